# Optimizing an MI355X kernel written in HIP

```python
import math
import jax, jax.numpy as jnp
from jax import lax
import numpy as np

D_MODEL = 1024
BATCH = 4
SEQ = 4096
DEPTH = 1

EPS = 1e-6
GMLP_WIDTH = 512
GMLP_GROUPS = 8
CHUNK = 128
N_HEADS = 8
HEAD_DIM = 64
ATTN_WIDTH = N_HEADS * HEAD_DIM
DILATED_PATTERNS = ((128, 1), (512, 4), (2048, 16))
Q_BLOCK = 128
N_EXPERTS = 16
EXPERT_HIDDEN = 1024
CAPACITY_FACTOR = 2
IN_COLS = 2 * GMLP_WIDTH + 3 * ATTN_WIDTH + 2 * D_MODEL

kernel_name = "hybrid_gmlp_dilated_attn_ec_moe"


def _rmsnorm(x, g):
    xf = x.astype(jnp.float32)
    y = xf * lax.rsqrt(jnp.mean(xf * xf, axis=-1, keepdims=True) + EPS)
    return (y * g.astype(jnp.float32)).astype(x.dtype)


def _gmlp_branch(u, v, gmlp_norm_g, w_spatial, b_spatial):
    B, S, _ = v.shape
    gd = GMLP_WIDTH // GMLP_GROUPS
    v = _rmsnorm(v, gmlp_norm_g)
    vc = v.reshape(B, S // CHUNK, CHUNK, GMLP_GROUPS, gd)
    mixed = jnp.einsum('gts,bcsgd->bctgd', w_spatial.astype(v.dtype), vc)
    mixed = mixed + b_spatial.T.astype(v.dtype)[None, None, :, :, None]
    return u * mixed.reshape(B, S, GMLP_WIDTH)


def _dilated_attention(q, k, v, slopes):
    B, H, S, hd = q.shape
    scale = hd ** -0.5
    n_blocks = S // Q_BLOCK

    def block(i):
        q0 = i * Q_BLOCK
        qb = lax.dynamic_slice_in_dim(q, q0, Q_BLOCK, axis=2).astype(jnp.float32)
        t = q0 + jnp.arange(Q_BLOCK)
        outs, lses = [], []
        for win, dil in DILATED_PATTERNS:
            half = win // (2 * dil)
            offs = dil * jnp.arange(-half, half + 1)
            pos = t[:, None] + offs[None, :]
            valid = (pos >= 0) & (pos < S)
            pos_c = jnp.clip(pos, 0, S - 1)
            kb = jnp.take(k, pos_c, axis=2).astype(jnp.float32)
            vb = jnp.take(v, pos_c, axis=2).astype(jnp.float32)
            s = jnp.einsum('bhqd,bhqkd->bhqk', qb, kb) * scale
            s = s - slopes[None, :, None, None] * jnp.abs(offs).astype(jnp.float32)[None, None, None, :]
            s = jnp.where(valid[None, None], s, -jnp.inf)
            m = jnp.max(s, axis=-1, keepdims=True)
            p = jnp.exp(s - m)
            den = jnp.sum(p, axis=-1)
            o = jnp.einsum('bhqk,bhqkd->bhqd', p, vb) / den[..., None]
            outs.append(o)
            lses.append(m[..., 0] + jnp.log(den))
        w = jax.nn.softmax(jnp.stack(lses, axis=0), axis=0)
        return jnp.sum(w[..., None] * jnp.stack(outs, axis=0), axis=0)

    o = lax.map(block, jnp.arange(n_blocks))
    o = o.transpose(1, 2, 0, 3, 4).reshape(B, H, S, hd)
    return o.astype(q.dtype)


def _expert_choice_moe(h, w_router, w_e_gate, w_e_up, w_e_down):
    B, S, D = h.shape
    cap = CAPACITY_FACTOR * S // N_EXPERTS
    logits = jnp.einsum('bsd,de->bse', h, w_router).astype(jnp.float32)
    aff = jax.nn.softmax(logits, axis=-1)
    gate, idx = lax.top_k(aff.transpose(0, 2, 1), cap)
    xe = jax.vmap(lambda hb, ib: hb[ib])(h, idx)
    g = jnp.einsum('becd,edf->becf', xe, w_e_gate)
    up = jnp.einsum('becd,edf->becf', xe, w_e_up)
    ye = jnp.einsum('becf,efd->becd', jax.nn.silu(g) * up, w_e_down)
    ye = ye * gate.astype(ye.dtype)[..., None]
    out = jax.vmap(lambda ib, yb: jnp.zeros((S, D), yb.dtype).at[ib.reshape(-1)].add(yb.reshape(-1, D)))(idx, ye)
    return out


def setup_inputs(seed: int = 0) -> dict:
    key = jax.random.key(seed)
    ks = jax.random.split(key, 20)
    f32 = jnp.float32
    L, D = DEPTH, D_MODEL
    nrm = lambda k, shape, fan_in: jax.random.normal(k, shape, f32) * (fan_in ** -0.5)
    gain = lambda k, shape: 1.0 + 0.05 * jax.random.normal(k, shape, f32)
    return {
        "x": jax.random.normal(ks[0], (BATCH, SEQ, D), f32),
        "norm_mix_g": gain(ks[1], (L, D)),
        "w_in": nrm(ks[2], (L, D, IN_COLS), D),
        "b_gate": 0.02 * jax.random.normal(ks[3], (L, 2 * D), f32),
        "gmlp_norm_g": gain(ks[4], (L, GMLP_WIDTH)),
        "w_spatial": nrm(ks[5], (L, GMLP_GROUPS, CHUNK, CHUNK), CHUNK),
        "b_spatial": gain(ks[6], (L, GMLP_GROUPS, CHUNK)),
        "w_proj_a": nrm(ks[7], (L, GMLP_WIDTH, D), GMLP_WIDTH),
        "w_proj_b": nrm(ks[8], (L, ATTN_WIDTH, D), ATTN_WIDTH),
        "w_out": nrm(ks[9], (L, D, D), D),
        "norm_ffn_g": gain(ks[10], (L, D)),
        "w_router": nrm(ks[11], (L, D, N_EXPERTS), D),
        "w_e_gate": nrm(ks[12], (L, N_EXPERTS, D, EXPERT_HIDDEN), D),
        "w_e_up": nrm(ks[13], (L, N_EXPERTS, D, EXPERT_HIDDEN), D),
        "w_e_down": nrm(ks[14], (L, N_EXPERTS, EXPERT_HIDDEN, D), EXPERT_HIDDEN),
        "norm_final_g": gain(ks[15], (D,)),
    }


def reference(x, norm_mix_g, w_in, b_gate, gmlp_norm_g, w_spatial, b_spatial, w_proj_a, w_proj_b,
              w_out, norm_ffn_g, w_router, w_e_gate, w_e_up, w_e_down, norm_final_g):
    B, S, D = x.shape
    slopes = 2.0 ** (-8.0 * jnp.arange(1, N_HEADS + 1, dtype=jnp.float32) / N_HEADS)
    splits = np.cumsum([GMLP_WIDTH, GMLP_WIDTH, ATTN_WIDTH, ATTN_WIDTH, ATTN_WIDTH, D_MODEL]).tolist()
    for l in range(DEPTH):
        h = _rmsnorm(x, norm_mix_g[l])
        proj = jnp.einsum('bsd,dc->bsc', h, w_in[l])
        u, v, q, k, va, ga, gb = jnp.split(proj, splits, axis=-1)
        ga = jax.nn.sigmoid(ga + b_gate[l, :D].astype(ga.dtype))
        gb = jax.nn.sigmoid(gb + b_gate[l, D:].astype(gb.dtype))
        a = _gmlp_branch(jax.nn.gelu(u), jax.nn.gelu(v), gmlp_norm_g[l], w_spatial[l], b_spatial[l])
        to_heads = lambda t: t.reshape(B, S, N_HEADS, HEAD_DIM).transpose(0, 2, 1, 3)
        o = _dilated_attention(to_heads(q), to_heads(k), to_heads(va), slopes)
        o = o.transpose(0, 2, 1, 3).reshape(B, S, ATTN_WIDTH)
        merged = ga * jnp.einsum('bsc,cd->bsd', a, w_proj_a[l]) + gb * jnp.einsum('bsc,cd->bsd', o, w_proj_b[l])
        x = x + jnp.einsum('bsd,de->bse', merged, w_out[l])
        h2 = _rmsnorm(x, norm_ffn_g[l])
        x = x + _expert_choice_moe(h2, w_router[l], w_e_gate[l], w_e_up[l], w_e_down[l])
    return _rmsnorm(x, norm_final_g)
```

```cpp
#include <hip/hip_runtime.h>
#include <hip/hip_cooperative_groups.h>
#include <cstdio>
#include <cstdint>

#ifndef MK_MODE
#define MK_MODE 2
#endif

#define LAS __attribute__((address_space(3)))
typedef unsigned short bf16_t;
typedef short bf16x8 __attribute__((ext_vector_type(8)));
typedef short s16x4 __attribute__((ext_vector_type(4)));
typedef float f32x2 __attribute__((ext_vector_type(2)));
typedef float f32x4 __attribute__((ext_vector_type(4)));
typedef float f32x16 __attribute__((ext_vector_type(16)));
typedef unsigned u32x2 __attribute__((ext_vector_type(2)));
typedef unsigned u32x4 __attribute__((ext_vector_type(4)));

constexpr int NB = 4, SEQ = 4096, T = NB * SEQ, D = 1024;
constexpr int GW = 512, AW = 512, NH = 8, HD = 64;
constexpr int INC = 2 * GW + 3 * AW + 2 * D;
constexpr int P1W = 2 * GW + 3 * AW;
constexpr int GTW = 2 * D;
constexpr int NE = 16, EH = 1024, CAP = 512;
constexpr int MROWS = NE * NB * CAP;
constexpr float EPS = 1e-6f;
constexpr float LOG2E = 1.4426950408889634f;
constexpr int NPH = 10;

constexpr size_t MiB = 1u << 20;
constexpr size_t WS_CTL = 0;
constexpr size_t WS_WSP = 1 * MiB;
constexpr size_t WS_GATE = 1 * MiB + 512 * 1024;
constexpr size_t WS_SLOT = 2 * MiB;
constexpr size_t WS_AFF = 3 * MiB;
constexpr size_t WS_PAT = 5 * MiB;
constexpr size_t WS_PBT = 6 * MiB;
constexpr size_t WS_WOT = 7 * MiB;
constexpr size_t WS_WGU = 9 * MiB;
constexpr size_t WS_WDT = 73 * MiB;
constexpr size_t WS_P1 = 105 * MiB;
constexpr size_t WS_MG = 105 * MiB;
constexpr size_t WS_XE = 105 * MiB;
constexpr size_t WS_Y = 105 * MiB;
constexpr size_t WS_ACT = 169 * MiB;
constexpr size_t WS_GT = 185 * MiB;
constexpr size_t WS_H = 249 * MiB;
constexpr size_t WS_A = 249 * MiB, WS_O = 265 * MiB;
constexpr size_t WS_END = 281 * MiB;
constexpr int SCR_STRIDE = 68;

__device__ __forceinline__ unsigned cvt_pk_bf16(float lo, float hi) { unsigned r; asm volatile("v_cvt_pk_bf16_f32 %0, %1, %2" : "=v"(r) : "v"(lo), "v"(hi)); return r; }
__device__ __forceinline__ float bf_lo(unsigned w) { return __uint_as_float(w << 16); }
__device__ __forceinline__ float bf_hi(unsigned w) { return __uint_as_float(w & 0xffff0000u); }
__device__ __forceinline__ float wave_sum(float v) {
#pragma unroll
    for (int o = 1; o < 64; o <<= 1) v += __shfl_xor(v, o);
    return v;
}
__device__ __forceinline__ int wave_sum_i(int v) {
#pragma unroll
    for (int o = 1; o < 64; o <<= 1) v += __shfl_xor(v, o);
    return v;
}
__device__ __forceinline__ float fast_sigmoid(float y) { return __builtin_amdgcn_rcpf(1.0f + __builtin_amdgcn_exp2f(-LOG2E * y)); }
__device__ __forceinline__ float gelu_tanh(float x) {
    const float z = 0.7978845608028654f * (x + 0.044715f * x * x * x);
    return x * __builtin_amdgcn_rcpf(1.0f + __builtin_amdgcn_exp2f(-2.0f * LOG2E * z));
}

namespace pg8 {
constexpr int BM = 256, BK = 64, HALF = 128, HTB = HALF * BK * 2, STAGE_BYTES = 8 * HTB, NXCD = 8, WGM = 8;
__host__ __device__ __forceinline__ int lds_byte(int r, int c) { const int st = (r >> 4) * 2 + (c >> 5), rr = r & 15, cc = c & 31, ob = rr * 64 + cc * 2; return st * 1024 + (ob ^ (((ob >> 9) & 1) << 5)); }
__host__ __device__ __forceinline__ void stage_rc(int b, int& R, int& C) { const int st = b / 1024, sb = b % 1024, swz = sb ^ (((sb >> 9) & 1) << 5); R = (st >> 1) * 16 + swz / 64; C = (st & 1) * 32 + (swz % 64) / 2; }
__host__ __device__ __forceinline__ int perm32(int rho) { const int n = rho >> 4, i = rho & 15; return 8 * (i >> 2) + 4 * n + (i & 3); }

struct Unit { int pm, pn; };
struct Gemm { const bf16_t* A; const bf16_t* Bt; int M, N, K; };

struct StaticOrder {
    int nM, nN, nwg, G, c, gsh, N;
    __device__ void init(int M, int N_, int G_, int c_, int gsh_) { nM = M / BM; nN = N_ / BM; nwg = nM * nN; G = G_; c = c_; gsh = gsh_; N = N_; }
    __device__ bool next(int i, Unit& u) const {
        const long L = (long)i * G + c; if (L >= nwg) return false;
        int wgid = (int)L; { const int q = nwg / NXCD, r = nwg % NXCD, xcd = wgid % NXCD, off = wgid / NXCD; wgid = (xcd < r ? xcd * (q + 1) : r * (q + 1) + (xcd - r) * q) + off; }
        const int nig = WGM * nN, gid = wgid / nig, fm = gid * WGM, gsz = (nM - fm) < WGM ? (nM - fm) : WGM;
        u.pm = fm + ((wgid % nig) % gsz); u.pn = (wgid % nig) / gsz; return true;
    }
    __device__ __forceinline__ int brow(const Unit& u) const { return (gsh >= 0 ? (u.pm >> gsh) * N : 0) + u.pn * BM; }
};

template <class Epi, bool ALIGN_EPI = true, bool SP2 = true>
__device__ __forceinline__ void gemm_phase(LAS unsigned char* lds, const Gemm g, const StaticOrder& S, const Epi& E) {
    const int tid = threadIdx.x, wid = __builtin_amdgcn_readfirstlane(tid >> 6), lane = tid & 63, wr = wid >> 2, wc = wid & 3, fr = lane & 15, fq = lane >> 4;
    const int K = g.K, nt = K / BK;
    unsigned voffA[2], voffB[2];
#pragma unroll
    for (int i = 0; i < 2; ++i) { int R, C; stage_rc(tid * 16 + i * 8192, R, C); const int Rb = Epi::PERM ? ((R & ~31) + perm32(R & 31)) : R;
        voffA[i] = (unsigned)(R * K + C) * 2u; voffB[i] = (unsigned)(Rb * K + C) * 2u; }
    const size_t kstep = (size_t)(BK * 2);
    const size_t hstep = (size_t)HALF * K * 2;
    const size_t tstep = 2 * hstep;
    const size_t rstep = (size_t)K * 2;
    const unsigned ldsw = (unsigned)wid * 1024u;
    const int aoff = lds_byte(wr * 64 + fr, fq * 8), boff = lds_byte(wc * 32 + fr, fq * 8);
#define PG8_SA(b, h) (((b) * 2 + (h)) * HTB)
#define PG8_SB(b, h) ((4 + (b) * 2 + (h)) * HTB)
#define PG8_STAGE(bufoff, gbase, voff) do { _Pragma("unroll") for (int _i = 0; _i < 2; ++_i) \
        __builtin_amdgcn_global_load_lds((const unsigned*)((const char*)(gbase) + (voff)[_i]), (LAS unsigned*)(lds + (bufoff) + ldsw + _i * 8192), 16, 0, 0); } while (0)
#define PG8_LDA(dst, b, h) do { _Pragma("unroll") for (int m = 0; m < 4; ++m) _Pragma("unroll") for (int k = 0; k < 2; ++k) dst[m][k] = *(const LAS bf16x8*)(lds + PG8_SA(b, h) + aoff + m * 2048 + k * 1024); } while (0)
#define PG8_LDB(dst, b, h) do { _Pragma("unroll") for (int n = 0; n < 2; ++n) _Pragma("unroll") for (int k = 0; k < 2; ++k) dst[n][k] = *(const LAS bf16x8*)(lds + PG8_SB(b, h) + boff + n * 2048 + k * 1024); } while (0)
#define PG8_MMA(ai, bj, At, Bt) do { __builtin_amdgcn_s_setprio(1); _Pragma("unroll") for (int m = 0; m < 4; ++m) _Pragma("unroll") for (int n = 0; n < 2; ++n) _Pragma("unroll") for (int k = 0; k < 2; ++k) \
        acc[ai][bj][m][n] = __builtin_amdgcn_mfma_f32_16x16x32_bf16(Bt[n][k], At[m][k], acc[ai][bj][m][n], 0, 0, 0); __builtin_amdgcn_s_setprio(0); } while (0)
#define PG8_WAIT_V(n) asm volatile("s_waitcnt vmcnt(" #n ")" ::: "memory")
#define PG8_WAIT_L(n) asm volatile("s_waitcnt lgkmcnt(" #n ")" ::: "memory")
#define PG8_BAR __builtin_amdgcn_s_barrier()
#define PG8_SCHED __builtin_amdgcn_sched_barrier(0)
    Unit cur, nxt; int ui = 0;
    if (!S.next(0, cur)) return;
    f32x4 acc[2][2][4][2];
#pragma unroll
    for (int a = 0; a < 2; ++a)
#pragma unroll
        for (int b = 0; b < 2; ++b)
#pragma unroll
            for (int m = 0; m < 4; ++m)
#pragma unroll
                for (int n = 0; n < 2; ++n) acc[a][b][m][n] = (f32x4){0.f, 0.f, 0.f, 0.f};
    bf16x8 At[4][2], B0[2][2], B1[2][2];
    const char* cA = (const char*)g.A + (size_t)cur.pm * tstep; const char* cB = (const char*)g.Bt + (size_t)S.brow(cur) * rstep;
    if constexpr (SP2) {
        PG8_STAGE(PG8_SB(0, 0), cB, voffB); PG8_STAGE(PG8_SB(0, 1), cB + hstep, voffB); PG8_STAGE(PG8_SA(0, 0), cA, voffA); PG8_STAGE(PG8_SA(0, 1), cA + hstep, voffA);
        if (wr == 1) PG8_BAR;
        PG8_WAIT_V(2); PG8_BAR;
        PG8_STAGE(PG8_SB(1, 0), cB + kstep, voffB); PG8_STAGE(PG8_SA(1, 0), cA + kstep, voffA); PG8_STAGE(PG8_SB(1, 1), cB + hstep + kstep, voffB);
        PG8_WAIT_V(6); PG8_BAR;
    } else {
        PG8_STAGE(PG8_SB(0, 0), cB, voffB); PG8_STAGE(PG8_SA(0, 0), cA, voffA); PG8_STAGE(PG8_SB(0, 1), cB + hstep, voffB); PG8_STAGE(PG8_SA(0, 1), cA + hstep, voffA);
        if (wr == 1) PG8_BAR;
        PG8_WAIT_V(4); PG8_BAR;
        PG8_STAGE(PG8_SB(1, 0), cB + kstep, voffB); PG8_STAGE(PG8_SA(1, 0), cA + kstep, voffA); PG8_STAGE(PG8_SB(1, 1), cB + hstep + kstep, voffB);
        PG8_WAIT_V(6); PG8_BAR;
    }
    for (;;) {
        const bool has_next = S.next(ui + 1, nxt);
        const char* nA = has_next ? (const char*)g.A + (size_t)nxt.pm * tstep : cA; const char* nB = has_next ? (const char*)g.Bt + (size_t)S.brow(nxt) * rstep : cB;
        for (int t = 0; t < nt; t += 2) {
            const bool last = (t == nt - 2);
            const char* a1 = cA + (size_t)(t + 1) * kstep;
            const char* a2 = last ? nA : cA + (size_t)(t + 2) * kstep; const char* b2 = last ? nB : cB + (size_t)(t + 2) * kstep;
            const char* a3 = a2 + kstep; const char* b3 = b2 + kstep;
            if constexpr (SP2) {
            PG8_LDB(B0, 0, 0); PG8_LDB(B1, 0, 1); PG8_SCHED; PG8_LDA(At, 0, 0); PG8_STAGE(PG8_SA(1, 1), a1 + hstep, voffA);
            PG8_WAIT_V(8); PG8_WAIT_L(0); PG8_BAR; PG8_MMA(0, 0, At, B0); PG8_MMA(0, 1, At, B1); PG8_BAR; PG8_SCHED;
            PG8_LDA(At, 0, 1); PG8_STAGE(PG8_SB(0, 0), b2, voffB); PG8_STAGE(PG8_SB(0, 1), b2 + hstep, voffB); PG8_STAGE(PG8_SA(0, 0), a2, voffA);
            PG8_WAIT_V(8); PG8_WAIT_L(0); PG8_BAR; PG8_MMA(1, 0, At, B0); PG8_MMA(1, 1, At, B1); PG8_BAR; PG8_SCHED;
            PG8_LDB(B0, 1, 0); PG8_LDB(B1, 1, 1); PG8_SCHED; PG8_LDA(At, 1, 0); PG8_STAGE(PG8_SA(0, 1), a2 + hstep, voffA);
            PG8_WAIT_V(8); PG8_WAIT_L(0); PG8_BAR; PG8_MMA(0, 0, At, B0); PG8_MMA(0, 1, At, B1); PG8_BAR; PG8_SCHED;
            PG8_LDA(At, 1, 1); PG8_STAGE(PG8_SB(1, 0), b3, voffB); PG8_STAGE(PG8_SB(1, 1), b3 + hstep, voffB); PG8_STAGE(PG8_SA(1, 0), a3, voffA);
            PG8_WAIT_V(8); PG8_WAIT_L(0); PG8_BAR; PG8_MMA(1, 0, At, B0); PG8_MMA(1, 1, At, B1); PG8_BAR; PG8_SCHED;
            } else {
            PG8_LDB(B0, 0, 0); PG8_SCHED; PG8_LDA(At, 0, 0); PG8_STAGE(PG8_SA(1, 1), a1 + hstep, voffA);
            PG8_WAIT_L(8); PG8_BAR; PG8_WAIT_L(0); PG8_MMA(0, 0, At, B0); PG8_BAR; PG8_SCHED;
            PG8_LDB(B1, 0, 1); PG8_STAGE(PG8_SB(0, 0), b2, voffB);
            PG8_BAR; PG8_WAIT_L(0); PG8_MMA(0, 1, At, B1); PG8_BAR;
            PG8_LDA(At, 0, 1); PG8_STAGE(PG8_SA(0, 0), a2, voffA);
            PG8_BAR; PG8_WAIT_L(0); PG8_MMA(1, 0, At, B0); PG8_BAR; PG8_SCHED;
            PG8_STAGE(PG8_SB(0, 1), b2 + hstep, voffB);
            PG8_WAIT_V(6); PG8_BAR; PG8_MMA(1, 1, At, B1); PG8_BAR;
            PG8_LDB(B0, 1, 0); PG8_SCHED; PG8_LDA(At, 1, 0); PG8_STAGE(PG8_SA(0, 1), a2 + hstep, voffA);
            PG8_WAIT_L(8); PG8_BAR; PG8_WAIT_L(0); PG8_MMA(0, 0, At, B0); PG8_BAR; PG8_SCHED;
            PG8_LDB(B1, 1, 1); PG8_STAGE(PG8_SB(1, 0), b3, voffB);
            PG8_BAR; PG8_WAIT_L(0); PG8_MMA(0, 1, At, B1); PG8_BAR;
            PG8_LDA(At, 1, 1); PG8_STAGE(PG8_SA(1, 0), a3, voffA);
            PG8_BAR; PG8_WAIT_L(0); PG8_MMA(1, 0, At, B0); PG8_BAR; PG8_SCHED;
            PG8_STAGE(PG8_SB(1, 1), b3 + hstep, voffB);
            PG8_WAIT_V(6); PG8_BAR; PG8_MMA(1, 1, At, B1); PG8_BAR;
            }
        }
        if constexpr (ALIGN_EPI) { if (wr == 0) PG8_BAR; }
        E(acc, cur, wr, wc, fr, fq);
        if (!has_next) break;
#pragma unroll
        for (int a = 0; a < 2; ++a)
#pragma unroll
            for (int b = 0; b < 2; ++b)
#pragma unroll
                for (int m = 0; m < 4; ++m)
#pragma unroll
                    for (int n = 0; n < 2; ++n) acc[a][b][m][n] = (f32x4){0.f, 0.f, 0.f, 0.f};
        cur = nxt; cA = nA; cB = nB; ++ui;
        if constexpr (ALIGN_EPI) { if (wr == 1) PG8_BAR; }
    }
    PG8_WAIT_V(0);
    if constexpr (!ALIGN_EPI) { if (wr == 0) PG8_BAR; }
    PG8_BAR;
#undef PG8_SA
#undef PG8_SB
#undef PG8_STAGE
#undef PG8_LDA
#undef PG8_LDB
#undef PG8_MMA
#undef PG8_WAIT_V
#undef PG8_WAIT_L
#undef PG8_BAR
#undef PG8_SCHED
}

typedef const f32x4 (&AccRef)[2][2][4][2];

struct EpiProj {
    static constexpr bool PERM = true;
    bf16_t* P1; bf16_t* GT; const float* bgate;
    __device__ __forceinline__ void operator()(AccRef acc, const Unit& u, int wr, int wc, int fr, int fq) const {
        const int pn = u.pn, row0 = u.pm * BM + wr * 64 + fr, cl = wc * 32 + 8 * fq;
        const bool isg = pn >= 10;
        bf16_t* base = isg ? GT + (pn - 10) * 256 + cl : P1 + pn * 256 + cl;
        const int ldc = isg ? GTW : P1W;
        const int mode = isg ? 3 : (pn < 4 ? 1 : (pn < 6 ? 2 : 0));
        f32x4 bv[2][2];
#pragma unroll
        for (int bj = 0; bj < 2; ++bj)
#pragma unroll
            for (int n = 0; n < 2; ++n) bv[bj][n] = isg ? *(const f32x4*)(bgate + (pn - 10) * 256 + bj * HALF + cl + 4 * n) : (f32x4){0.f, 0.f, 0.f, 0.f};
#pragma unroll
        for (int ai = 0; ai < 2; ++ai)
#pragma unroll
            for (int m = 0; m < 4; ++m) { bf16_t* rowp = base + (size_t)(row0 + ai * HALF + m * 16) * ldc;
#pragma unroll
                for (int bj = 0; bj < 2; ++bj) { f32x4 v0 = acc[ai][bj][m][0], v1 = acc[ai][bj][m][1];
                    if (mode == 1) {
#pragma unroll
                        for (int j = 0; j < 4; ++j) { v0[j] = gelu_tanh(v0[j]); v1[j] = gelu_tanh(v1[j]); } }
                    else if (mode == 2) { v0 = v0 * (0.125f * LOG2E); v1 = v1 * (0.125f * LOG2E); }
                    else if (mode == 3) { v0 = v0 + bv[bj][0]; v1 = v1 + bv[bj][1];
#pragma unroll
                        for (int j = 0; j < 4; ++j) { v0[j] = fast_sigmoid(v0[j]); v1[j] = fast_sigmoid(v1[j]); } }
                    u32x4 w; w.x = cvt_pk_bf16(v0[0], v0[1]); w.y = cvt_pk_bf16(v0[2], v0[3]); w.z = cvt_pk_bf16(v1[0], v1[1]); w.w = cvt_pk_bf16(v1[2], v1[3]);
                    *(u32x4*)(rowp + bj * HALF) = w; } }
    }
};
struct EpiGateA {
    static constexpr bool PERM = false;
    float* M1; const bf16_t* GT;
    __device__ __forceinline__ void operator()(AccRef acc, const Unit& u, int wr, int wc, int fr, int fq) const {
        const int row0 = u.pm * BM + wr * 64 + fr, col0 = u.pn * BM + wc * 32 + 4 * fq;
#pragma unroll
        for (int ai = 0; ai < 2; ++ai)
#pragma unroll
            for (int m = 0; m < 4; ++m) { const size_t r = (size_t)(row0 + ai * HALF + m * 16);
#pragma unroll
                for (int bj = 0; bj < 2; ++bj)
#pragma unroll
                    for (int n = 0; n < 2; ++n) { const int c = col0 + bj * HALF + n * 16; const u32x2 gw = *(const u32x2*)(GT + r * GTW + c);
                        const f32x4 gv = (f32x4){bf_lo(gw.x), bf_hi(gw.x), bf_lo(gw.y), bf_hi(gw.y)};
                        *(f32x4*)(M1 + r * D + c) = acc[ai][bj][m][n] * gv; } }
    }
};
struct EpiGateB {
    static constexpr bool PERM = false;
    const float* M1; const bf16_t* GT; bf16_t* MG;
    __device__ __forceinline__ void operator()(AccRef acc, const Unit& u, int wr, int wc, int fr, int fq) const {
        const int row0 = u.pm * BM + wr * 64 + fr, col0 = u.pn * BM + wc * 32 + 4 * fq;
#pragma unroll
        for (int ai = 0; ai < 2; ++ai)
#pragma unroll
            for (int m = 0; m < 4; ++m) { const size_t r = (size_t)(row0 + ai * HALF + m * 16);
#pragma unroll
                for (int bj = 0; bj < 2; ++bj)
#pragma unroll
                    for (int n = 0; n < 2; ++n) { const int c = col0 + bj * HALF + n * 16; const u32x2 gw = *(const u32x2*)(GT + r * GTW + D + c);
                        const f32x4 gv = (f32x4){bf_lo(gw.x), bf_hi(gw.x), bf_lo(gw.y), bf_hi(gw.y)};
                        const f32x4 o = *(const f32x4*)(M1 + r * D + c) + acc[ai][bj][m][n] * gv;
                        u32x2 w; w.x = cvt_pk_bf16(o[0], o[1]); w.y = cvt_pk_bf16(o[2], o[3]); *(u32x2*)(MG + r * D + c) = w; } }
    }
};
struct EpiResid {
    static constexpr bool PERM = false;
    const float* X; float* X1;
    __device__ __forceinline__ void operator()(AccRef acc, const Unit& u, int wr, int wc, int fr, int fq) const {
        const int row0 = u.pm * BM + wr * 64 + fr, col0 = u.pn * BM + wc * 32 + 4 * fq;
#pragma unroll
        for (int ai = 0; ai < 2; ++ai)
#pragma unroll
            for (int m = 0; m < 4; ++m) { const size_t r = (size_t)(row0 + ai * HALF + m * 16);
#pragma unroll
                for (int bj = 0; bj < 2; ++bj)
#pragma unroll
                    for (int n = 0; n < 2; ++n) { const int c = col0 + bj * HALF + n * 16;
                        *(f32x4*)(X1 + r * D + c) = *(const f32x4*)(X + r * D + c) + acc[ai][bj][m][n]; } }
    }
};
struct EpiSwiGLU {
    static constexpr bool PERM = true;
    bf16_t* ACT;
    __device__ __forceinline__ void operator()(AccRef acc, const Unit& u, int wr, int wc, int fr, int fq) const {
        const int row0 = u.pm * BM + wr * 64 + fr, col0 = u.pn * HALF + wc * 32 + 8 * fq;
#pragma unroll
        for (int ai = 0; ai < 2; ++ai)
#pragma unroll
            for (int m = 0; m < 4; ++m) { bf16_t* rowp = ACT + (size_t)(row0 + ai * HALF + m * 16) * EH + col0;
                f32x4 o[2];
#pragma unroll
                for (int n = 0; n < 2; ++n) { const f32x4 gg = acc[ai][0][m][n], uu = acc[ai][1][m][n];
#pragma unroll
                    for (int j = 0; j < 4; ++j) o[n][j] = gg[j] * fast_sigmoid(gg[j]) * uu[j]; }
                u32x4 w; w.x = cvt_pk_bf16(o[0][0], o[0][1]); w.y = cvt_pk_bf16(o[0][2], o[0][3]); w.z = cvt_pk_bf16(o[1][0], o[1][1]); w.w = cvt_pk_bf16(o[1][2], o[1][3]);
                *(u32x4*)rowp = w; }
    }
};
struct EpiDown {
    static constexpr bool PERM = true;
    bf16_t* Y; const float* gate;
    __device__ __forceinline__ void operator()(AccRef acc, const Unit& u, int wr, int wc, int fr, int fq) const {
        const int row0 = u.pm * BM + wr * 64 + fr, col0 = u.pn * BM + wc * 32 + 8 * fq;
#pragma unroll
        for (int ai = 0; ai < 2; ++ai)
#pragma unroll
            for (int m = 0; m < 4; ++m) { const int r = row0 + ai * HALF + m * 16; const float gt = gate[r]; bf16_t* rowp = Y + (size_t)r * D + col0;
#pragma unroll
                for (int bj = 0; bj < 2; ++bj) { const f32x4 v0 = acc[ai][bj][m][0] * gt, v1 = acc[ai][bj][m][1] * gt;
                    u32x4 w; w.x = cvt_pk_bf16(v0[0], v0[1]); w.y = cvt_pk_bf16(v0[2], v0[3]); w.z = cvt_pk_bf16(v1[0], v1[1]); w.w = cvt_pk_bf16(v1[2], v1[3]);
                    *(u32x4*)(rowp + bj * HALF) = w; } }
    }
};
}

#define XB_TMO      128
#define XB_XCNT(j)  (256  + 64 * (j))
#define XB_XSUB(j)  (1280 + 64 * (j))
#define XB_XGEN(j)  (2304 + 64 * (j))
#define XB_TOP      3328
#define XB_TOPGEN   3392
#define XCD_BAR_WORDS 3456
#define XB_SPIN_CAP (1u << 18)
__device__ __forceinline__ unsigned xb_ld(unsigned* p)              { return __hip_atomic_load(p, __ATOMIC_RELAXED, __HIP_MEMORY_SCOPE_AGENT); }
__device__ __forceinline__ unsigned xb_add(unsigned* p, unsigned v) { return __hip_atomic_fetch_add(p, v, __ATOMIC_RELAXED, __HIP_MEMORY_SCOPE_AGENT); }
__device__ __forceinline__ unsigned xb_xcc_id() { return (unsigned)__builtin_amdgcn_s_getreg((3 << 11) | 20) & 0xFu; }
#define XB_SPIN(cond, bar) do { unsigned _sp = 0; while (cond) { __builtin_amdgcn_s_sleep(1); \
    if ((++_sp & 255u) == 0u) { if (xb_ld(&(bar)[XB_TMO])) break; if (_sp > XB_SPIN_CAP) { atomicAdd(&(bar)[XB_TMO], 1u); break; } } } } while (0)
struct XcdBarrier { unsigned* bar; unsigned x; volatile LAS unsigned* st; };
__device__ __forceinline__ XcdBarrier xcd_barrier_post(unsigned* bar, volatile LAS unsigned* st) {
    XcdBarrier b; b.bar = bar; b.x = xb_xcc_id(); b.st = st;
    if (threadIdx.x == 0) (void)xb_add(&bar[XB_XCNT(b.x)], 1u);
    return b;
}
__device__ __forceinline__ void xcd_barrier_complete(unsigned* bar, unsigned x, unsigned& nloc, unsigned& nx) {
    const unsigned G = gridDim.x * gridDim.y * gridDim.z;
    unsigned sum, cnt, mine, sp = 0u;
    for (;;) {
        sum = 0u; cnt = 0u; mine = 0u;
#pragma unroll
        for (unsigned j = 0; j < 16; ++j) { const unsigned c = xb_ld(&bar[XB_XCNT(j)]); sum += c; cnt += (c > 0u) ? 1u : 0u; mine = (j == x) ? c : mine; }
        if (sum == G) break;
        __builtin_amdgcn_s_sleep(1);
        if ((++sp & 255u) == 0u) { if (xb_ld(&bar[XB_TMO])) break; if (sp > XB_SPIN_CAP) { atomicAdd(&bar[XB_TMO], 1u); break; } }
    }
    nloc = mine > 0u ? mine : 1u; nx = cnt > 0u ? cnt : 1u;
}
__device__ __forceinline__ void xcd_barrier(const XcdBarrier& b) {
    asm volatile("s_waitcnt vmcnt(0)" ::: "memory");
    __syncthreads();
    if (threadIdx.x == 0) {
        unsigned* bar = b.bar;
        __builtin_amdgcn_s_waitcnt(0);
        unsigned nloc = b.st[0], nx = b.st[1];
        if (nloc == 0u) { xcd_barrier_complete(bar, b.x, nloc, nx); b.st[0] = nloc; b.st[1] = nx; }
        const unsigned old = xb_add(&bar[XB_XSUB(b.x)], 1u);
        const unsigned gen = old / nloc;
        if (old + 1u == (gen + 1u) * nloc) {
            __builtin_amdgcn_fence(__ATOMIC_RELEASE, "agent");
            asm volatile("s_waitcnt vmcnt(0)" ::: "memory");
            const unsigned og = xb_add(&bar[XB_TOP], 1u);
            const unsigned tg = og / nx;
            if (og + 1u == (tg + 1u) * nx) xb_add(&bar[XB_TOPGEN], 1u);
            else XB_SPIN(xb_ld(&bar[XB_TOPGEN]) == tg, bar);
            __builtin_amdgcn_fence(__ATOMIC_ACQUIRE, "agent");
            xb_add(&bar[XB_XGEN(b.x)], 1u);
            asm volatile("s_waitcnt vmcnt(0)" ::: "memory");
        } else {
            XB_SPIN(xb_ld(&bar[XB_XGEN(b.x)]) == gen, bar);
            __builtin_amdgcn_fence(__ATOMIC_ACQUIRE, "agent");
            asm volatile("s_waitcnt vmcnt(0)" ::: "memory");
        }
    }
    __syncthreads();
}

constexpr int NWAVES = 8;
constexpr int LDS_BYTES = 147456;
constexpr int MISC_OFF = 144 * 1024 - 256;
constexpr int CW_BAR = 4096;

struct Args { const float* in[16]; float* out; unsigned char* ws; int ph_lo, ph_hi; };

__device__ __forceinline__ void transpose_tile(const float* W, int N, int k0, int n0, bf16_t* WT, int Kd, int drow0, LAS float* scr, int lane) {
    const int n4 = (lane & 15) * 4, kq = lane >> 4;
#pragma unroll 4
    for (int i = 0; i < 16; ++i) { const int k = 4 * i + kq; const f32x4 v = *(const f32x4*)(W + (size_t)(k0 + k) * N + n0 + n4);
        LAS float* s = scr + k * 65 + n4; s[0] = v[0]; s[1] = v[1]; s[2] = v[2]; s[3] = v[3]; }
    asm volatile("s_waitcnt lgkmcnt(0)" ::: "memory");
    const int c = lane & 7;
#pragma unroll
    for (int jj = 0; jj < 8; ++jj) { const int n = (lane >> 3) + 8 * jj; const LAS float* s = scr + (8 * c) * 65 + n;
        u32x4 o; o.x = cvt_pk_bf16(s[0], s[65]); o.y = cvt_pk_bf16(s[2 * 65], s[3 * 65]); o.z = cvt_pk_bf16(s[4 * 65], s[5 * 65]); o.w = cvt_pk_bf16(s[6 * 65], s[7 * 65]);
        *(u32x4*)(WT + (size_t)(drow0 + n) * Kd + k0 + 8 * c) = o; }
    asm volatile("s_waitcnt lgkmcnt(0)" ::: "memory");
}
__device__ __forceinline__ void rms_row_to_bf16(const float* xrow, const f32x4 (&gg)[4], bf16_t* orow, int lane) {
    f32x4 v[4]; float s = 0.f;
#pragma unroll
    for (int j = 0; j < 4; ++j) { v[j] = *((const f32x4*)xrow + lane + 64 * j); s += (v[j].x * v[j].x + v[j].y * v[j].y) + (v[j].z * v[j].z + v[j].w * v[j].w); }
    const float r = 1.0f / sqrtf(wave_sum(s) * (1.0f / D) + EPS);
#pragma unroll
    for (int j = 0; j < 4; ++j) { const f32x4 o = v[j] * r * gg[j]; u32x2 w; w.x = cvt_pk_bf16(o[0], o[1]); w.y = cvt_pk_bf16(o[2], o[3]); *((u32x2*)orow + lane + 64 * j) = w; }
}

__device__ __forceinline__ s16x4 tr_read(const LAS unsigned char* p) {
    typedef short v4i16_t __attribute__((ext_vector_type(4)));
    return __builtin_bit_cast(s16x4, __builtin_amdgcn_ds_read_tr16_b64_v4i16((LAS v4i16_t*)p));
}

__global__ void __launch_bounds__(NWAVES * 64, 2) mk_fwd(Args args) {
    extern __shared__ __attribute__((aligned(16))) unsigned char lds_raw[];
    LAS unsigned char* lds = (LAS unsigned char*)lds_raw;
    const int tid = threadIdx.x, lane = tid & 63, wave = __builtin_amdgcn_readfirstlane(tid >> 6);
    const int G = gridDim.x, bx = blockIdx.x;
    const int vcu = (G % 8 == 0) ? (bx % 8) * (G / 8) + bx / 8 : bx;
    const int gw = vcu * NWAVES + wave, NGW = G * NWAVES;
    unsigned char* ws = args.ws;
    float* OUT = args.out;
    const float* X = args.in[0];
    bf16_t* WSP = (bf16_t*)(ws + WS_WSP); float* GATE = (float*)(ws + WS_GATE); short* SLOT = (short*)(ws + WS_SLOT); float* AFF = (float*)(ws + WS_AFF);
    bf16_t* PAT = (bf16_t*)(ws + WS_PAT); bf16_t* PBT = (bf16_t*)(ws + WS_PBT); bf16_t* WOT = (bf16_t*)(ws + WS_WOT);
    bf16_t* WGU = (bf16_t*)(ws + WS_WGU); bf16_t* WDT = (bf16_t*)(ws + WS_WDT);
    bf16_t* P1 = (bf16_t*)(ws + WS_P1); bf16_t* MG = (bf16_t*)(ws + WS_MG); bf16_t* XE = (bf16_t*)(ws + WS_XE); bf16_t* YB = (bf16_t*)(ws + WS_Y);
    bf16_t* ACT = (bf16_t*)(ws + WS_ACT); bf16_t* GT = (bf16_t*)(ws + WS_GT);
    bf16_t* HB = (bf16_t*)(ws + WS_H); bf16_t* AB = (bf16_t*)(ws + WS_A); bf16_t* OB = (bf16_t*)(ws + WS_O);
    bf16_t* WIT = (bf16_t*)OUT;
    float* SCR = OUT;

#if MK_MODE == 2
    volatile LAS unsigned* MISC = (volatile LAS unsigned*)(lds + MISC_OFF);
    if (tid < 64) MISC[tid] = 0u;
    __syncthreads();
    XcdBarrier bar = xcd_barrier_post((unsigned*)(ws + WS_CTL) + CW_BAR, MISC + 8);
#define GRID_BAR() xcd_barrier(bar)
#elif MK_MODE == 1
#define GRID_BAR() cooperative_groups::this_grid().sync()
#else
#define GRID_BAR() do {} while (0)
#endif
    const int lo = args.ph_lo, hi = args.ph_hi;
#define IN(k) (lo <= (k) && (k) < hi)
#define SEAM(k) do { if (IN(k) && IN((k) + 1)) GRID_BAR(); } while (0)

    if (IN(0)) {
        LAS float* scr = (LAS float*)(lds + wave * 16640);
        constexpr int I_IN = 16 * 72, I_PA = 8 * 16, I_WO = 16 * 16, I_EX = 16 * 16;
        constexpr int NITEMS = I_IN + 2 * I_PA + I_WO + 48 * I_EX;
        for (int it = gw; it < NITEMS; it += NGW) {
            int r = it;
            if (r < I_IN) { transpose_tile(args.in[2], INC, 64 * (r / 72), 64 * (r % 72), WIT, D, 64 * (r % 72), scr, lane); continue; } r -= I_IN;
            if (r < I_PA) { transpose_tile(args.in[7], D, 64 * (r / 16), 64 * (r % 16), PAT, GW, 64 * (r % 16), scr, lane); continue; } r -= I_PA;
            if (r < I_PA) { transpose_tile(args.in[8], D, 64 * (r / 16), 64 * (r % 16), PBT, AW, 64 * (r % 16), scr, lane); continue; } r -= I_PA;
            if (r < I_WO) { transpose_tile(args.in[9], D, 64 * (r / 16), 64 * (r % 16), WOT, D, 64 * (r % 16), scr, lane); continue; } r -= I_WO;
            const int e = r / (3 * I_EX), q = r % (3 * I_EX), kind = q / I_EX, t = q % I_EX, k0 = 64 * (t / 16), n0 = 64 * (t % 16);
            if (kind < 2) transpose_tile(args.in[12 + kind] + (size_t)e * D * EH, EH, k0, n0, WGU + (size_t)e * 2048 * D, D, 256 * (n0 >> 7) + 128 * kind + (n0 & 127), scr, lane);
            else transpose_tile(args.in[14] + (size_t)e * EH * D, D, k0, n0, WDT + (size_t)e * D * EH, EH, n0, scr, lane);
        }
        { const float* wsrc = args.in[5];
          for (int i = (vcu * 512 + tid) * 4; i < 8 * 128 * 128; i += G * 512 * 4) { const f32x4 v = *(const f32x4*)(wsrc + i); u32x2 w; w.x = cvt_pk_bf16(v[0], v[1]); w.y = cvt_pk_bf16(v[2], v[3]); *(u32x2*)(WSP + i) = w; } }
        f32x4 gg[4];
#pragma unroll
        for (int j = 0; j < 4; ++j) gg[j] = *((const f32x4*)args.in[1] + lane + 64 * j);
        for (int m = gw; m < T; m += NGW) rms_row_to_bf16(X + (size_t)m * D, gg, HB + (size_t)m * D, lane);
    }
    SEAM(0);

    if (IN(1)) {
        pg8::Gemm g{HB, WIT, T, INC, D}; pg8::StaticOrder S; S.init(T, INC, G, bx, -1);
        pg8::EpiProj E{P1, GT, args.in[3]};
        pg8::gemm_phase<pg8::EpiProj>(lds, g, S, E);
    }
    SEAM(1);

    if (IN(2)) {
        for (int item = vcu; item < NB * NH * 8; item += G) {
            const int bh = item >> 3, blk = item & 7, b = bh >> 3, hd = bh & 7, Q0 = blk * 512;
            const float slope2 = __builtin_amdgcn_exp2f(-(float)(hd + 1)) * LOG2E;
            const bf16_t* qp = P1 + (size_t)b * SEQ * P1W + 1024 + 64 * hd; const bf16_t* kp = qp + 512; const bf16_t* vp = qp + 1024;
            LAS unsigned char* Kt = lds + wave * 10752; LAS unsigned char* Vt = Kt + 4608;
            const int c = lane & 31, h = lane >> 5, gi = lane & 15, g1 = (lane >> 4) & 1;
            float* scrI = SCR + (size_t)item * (512 * SCR_STRIDE);
            for (int pi = 0; pi < 3; ++pi) {
                const int dls = 4 - 2 * pi, nseq = SEQ >> dls;
                const float pen = slope2 * (float)(1 << dls);
                for (int uu = 0; uu < 2; ++uu) {
                    const int u = wave + 8 * uu, ql = 4 - dls, r = u >> ql, qt = u & ((1 << ql) - 1);
                    const int nq0 = (Q0 >> dls) + 32 * qt, tq = r + ((nq0 + c) << dls), qi = tq - Q0, nb = nq0 - 64;
                    bf16x8 qf[4];
                    { const bf16_t* qrow = qp + (size_t)tq * P1W + 8 * h;
#pragma unroll
                      for (int ks = 0; ks < 4; ++ks) qf[ks] = *(const bf16x8*)(qrow + 16 * ks); }
                    f32x16 o0, o1; float m, l;
                    float* sp = scrI + (size_t)qi * SCR_STRIDE;
                    if (pi == 0) {
#pragma unroll
                        for (int i = 0; i < 16; ++i) { o0[i] = 0.f; o1[i] = 0.f; }
                        m = -1e30f; l = 0.f;
                    } else {
#pragma unroll
                        for (int rg = 0; rg < 4; ++rg) { const f32x4 a = *(const f32x4*)(sp + 8 * rg + 4 * h), bq = *(const f32x4*)(sp + 32 + 8 * rg + 4 * h);
#pragma unroll
                            for (int j = 0; j < 4; ++j) { o0[4 * rg + j] = a[j]; o1[4 * rg + j] = bq[j]; } }
                        m = sp[64]; l = sp[65];
                    }
                    u32x4 kr[4], vr[4];
#define ATT_LOAD(kt) do { _Pragma("unroll") for (int it = 0; it < 4; ++it) { int nk = nb + 32 * (kt) + (lane >> 3) + 8 * it; nk = nk < 0 ? 0 : (nk > nseq - 1 ? nseq - 1 : nk); \
                        const size_t off = (size_t)(r + (nk << dls)) * P1W + 8 * (lane & 7); kr[it] = *(const u32x4*)(kp + off); vr[it] = *(const u32x4*)(vp + off); } } while (0)
                    ATT_LOAD(0);
#pragma unroll 1
                    for (int kt = 0; kt < 5; ++kt) {
#pragma unroll
                        for (int it = 0; it < 4; ++it) { const int row = (lane >> 3) + 8 * it; *(LAS u32x4*)(Kt + row * 144 + 16 * (lane & 7)) = kr[it]; *(LAS u32x4*)(Vt + row * 192 + 16 * (lane & 7)) = vr[it]; }
                        if (kt < 4) ATT_LOAD(kt + 1);
                        f32x16 s;
#pragma unroll
                        for (int i = 0; i < 16; ++i) s[i] = 0.f;
#pragma unroll
                        for (int ks = 0; ks < 4; ++ks) { const bf16x8 kf = *(const LAS bf16x8*)(Kt + c * 144 + 32 * ks + 16 * h); s = __builtin_amdgcn_mfma_f32_32x32x16_bf16(kf, qf[ks], s, 0, 0, 0); }
                        float mx = -INFINITY;
#pragma unroll
                        for (int i = 0; i < 16; ++i) { const int rho = (i & 3) + 8 * (i >> 2) + 4 * h; const int j = 32 * kt + rho - 64 - c; const int nk = nb + 32 * kt + rho; const int aj = j < 0 ? -j : j;
                            const bool valid = (aj <= 64) && (nk >= 0) && (nk < nseq);
                            s[i] = valid ? s[i] - pen * (float)aj : -INFINITY; mx = fmaxf(mx, s[i]); }
                        mx = fmaxf(mx, __shfl_xor(mx, 32));
                        const float mn = fmaxf(m, mx), alpha = __builtin_amdgcn_exp2f(m - mn);
                        float rs = 0.f;
#pragma unroll
                        for (int i = 0; i < 16; ++i) { s[i] = __builtin_amdgcn_exp2f(s[i] - mn); rs += s[i]; }
                        rs += __shfl_xor(rs, 32);
                        l = l * alpha + rs; m = mn;
#pragma unroll
                        for (int i = 0; i < 16; ++i) { o0[i] *= alpha; o1[i] *= alpha; }
                        bf16x8 pf[2];
#pragma unroll
                        for (int s2 = 0; s2 < 2; ++s2) { const unsigned w0 = cvt_pk_bf16(s[8 * s2 + 0], s[8 * s2 + 1]), w1 = cvt_pk_bf16(s[8 * s2 + 2], s[8 * s2 + 3]), w2 = cvt_pk_bf16(s[8 * s2 + 4], s[8 * s2 + 5]), w3 = cvt_pk_bf16(s[8 * s2 + 6], s[8 * s2 + 7]);
                            pf[s2] = __builtin_bit_cast(bf16x8, (u32x4){w0, w1, w2, w3}); }
#pragma unroll
                        for (int s2 = 0; s2 < 2; ++s2)
#pragma unroll
                            for (int dt = 0; dt < 2; ++dt) { const LAS unsigned char* vb = Vt + (16 * s2 + 4 * h + (gi >> 2)) * 192 + (32 * dt + 16 * g1 + 4 * (gi & 3)) * 2;
                                const s16x4 vlo = tr_read(vb), vhi = tr_read(vb + 8 * 192);
                                const bf16x8 vf = (bf16x8){vlo[0], vlo[1], vlo[2], vlo[3], vhi[0], vhi[1], vhi[2], vhi[3]};
                                if (dt == 0) o0 = __builtin_amdgcn_mfma_f32_32x32x16_bf16(vf, pf[s2], o0, 0, 0, 0); else o1 = __builtin_amdgcn_mfma_f32_32x32x16_bf16(vf, pf[s2], o1, 0, 0, 0); }
                    }
#undef ATT_LOAD
                    if (pi < 2) {
#pragma unroll
                        for (int rg = 0; rg < 4; ++rg) { *(f32x4*)(sp + 8 * rg + 4 * h) = (f32x4){o0[4 * rg], o0[4 * rg + 1], o0[4 * rg + 2], o0[4 * rg + 3]};
                            *(f32x4*)(sp + 32 + 8 * rg + 4 * h) = (f32x4){o1[4 * rg], o1[4 * rg + 1], o1[4 * rg + 2], o1[4 * rg + 3]}; }
                        if (h == 0) { sp[64] = m; sp[65] = l; }
                    } else {
                        const float inv = 1.0f / l; bf16_t* op = OB + (size_t)(b * SEQ + tq) * AW + 64 * hd + 4 * h;
#pragma unroll
                        for (int rg = 0; rg < 4; ++rg) { u32x2 w; w.x = cvt_pk_bf16(o0[4 * rg] * inv, o0[4 * rg + 1] * inv); w.y = cvt_pk_bf16(o0[4 * rg + 2] * inv, o0[4 * rg + 3] * inv); *(u32x2*)(op + 8 * rg) = w;
                            w.x = cvt_pk_bf16(o1[4 * rg] * inv, o1[4 * rg + 1] * inv); w.y = cvt_pk_bf16(o1[4 * rg + 2] * inv, o1[4 * rg + 3] * inv); *(u32x2*)(op + 32 + 8 * rg) = w; }
                    }
                }
                __syncthreads();
            }
        }
        for (int item = vcu; item < 256; item += G) {
            const int ch = item >> 1, hh = item & 1; const size_t t0 = (size_t)ch * 128;
            LAS float* rsq = (LAS float*)lds; LAS unsigned char* VN = lds + 512;
            __syncthreads();
            for (int i = 0; i < 16; ++i) { const int s = wave * 16 + i; const u32x4 raw = *(const u32x4*)(P1 + (t0 + s) * P1W + GW + 8 * lane);
                float ss = 0.f;
#pragma unroll
                for (int j = 0; j < 4; ++j) { const float a = bf_lo(raw[j]), bq = bf_hi(raw[j]); ss += a * a + bq * bq; }
                ss = wave_sum(ss); if (lane == 0) rsq[s] = 1.0f / sqrtf(ss * (1.0f / GW) + EPS); }
            __syncthreads();
            for (int i = 0; i < 8; ++i) { const int id = tid + 512 * i, row = id >> 5, cc = id & 31; const u32x4 raw = *(const u32x4*)(P1 + (t0 + row) * P1W + GW + 256 * hh + 8 * cc);
                const float rr = rsq[row]; const f32x4 g0 = *(const f32x4*)(args.in[4] + 256 * hh + 8 * cc), g1v = *(const f32x4*)(args.in[4] + 256 * hh + 8 * cc + 4);
                u32x4 w; w.x = cvt_pk_bf16(bf_lo(raw.x) * rr * g0[0], bf_hi(raw.x) * rr * g0[1]); w.y = cvt_pk_bf16(bf_lo(raw.y) * rr * g0[2], bf_hi(raw.y) * rr * g0[3]);
                w.z = cvt_pk_bf16(bf_lo(raw.z) * rr * g1v[0], bf_hi(raw.z) * rr * g1v[1]); w.w = cvt_pk_bf16(bf_lo(raw.w) * rr * g1v[2], bf_hi(raw.w) * rr * g1v[3]);
                *(LAS u32x4*)(VN + row * 576 + 16 * cc) = w; }
            __syncthreads();
            {
                const int gl = wave >> 1, th = wave & 1, grp = 4 * hh + gl, c = lane & 31, h = lane >> 5, gi = lane & 15, g1 = (lane >> 4) & 1;
                f32x16 acc[2][2];
#pragma unroll
                for (int a = 0; a < 2; ++a)
#pragma unroll
                    for (int bq = 0; bq < 2; ++bq)
#pragma unroll
                        for (int i = 0; i < 16; ++i) acc[a][bq][i] = 0.f;
                const bf16_t* wbase = WSP + ((size_t)grp * 128 + 64 * th + c) * 128 + 8 * h;
#pragma unroll 2
                for (int ks = 0; ks < 8; ++ks) {
                    bf16x8 wf[2], af[2];
#pragma unroll
                    for (int tt = 0; tt < 2; ++tt) wf[tt] = *(const bf16x8*)(wbase + (size_t)(32 * tt) * 128 + 16 * ks);
#pragma unroll
                    for (int dt = 0; dt < 2; ++dt) { const LAS unsigned char* vb = VN + (16 * ks + 8 * h + (gi >> 2)) * 576 + (64 * gl + 32 * dt + 16 * g1 + 4 * (gi & 3)) * 2;
                        const s16x4 vlo = tr_read(vb), vhi = tr_read(vb + 4 * 576);
                        af[dt] = (bf16x8){vlo[0], vlo[1], vlo[2], vlo[3], vhi[0], vhi[1], vhi[2], vhi[3]}; }
#pragma unroll
                    for (int dt = 0; dt < 2; ++dt)
#pragma unroll
                        for (int tt = 0; tt < 2; ++tt) acc[dt][tt] = __builtin_amdgcn_mfma_f32_32x32x16_bf16(af[dt], wf[tt], acc[dt][tt], 0, 0, 0);
                }
#pragma unroll
                for (int tt = 0; tt < 2; ++tt) { const int tl = 64 * th + 32 * tt + c; const size_t row = t0 + tl; const float bias = args.in[6][grp * 128 + tl];
#pragma unroll
                    for (int dt = 0; dt < 2; ++dt)
#pragma unroll
                        for (int rg = 0; rg < 4; ++rg) { const int col = 64 * grp + 32 * dt + 8 * rg + 4 * h; const u32x2 uw = *(const u32x2*)(P1 + row * P1W + col);
                            const float a0 = bf_lo(uw.x) * (acc[dt][tt][4 * rg] + bias), a1 = bf_hi(uw.x) * (acc[dt][tt][4 * rg + 1] + bias), a2 = bf_lo(uw.y) * (acc[dt][tt][4 * rg + 2] + bias), a3 = bf_hi(uw.y) * (acc[dt][tt][4 * rg + 3] + bias);
                            u32x2 w; w.x = cvt_pk_bf16(a0, a1); w.y = cvt_pk_bf16(a2, a3); *(u32x2*)(AB + row * GW + col) = w; } }
            }
            __syncthreads();
        }
    }
    SEAM(2);

    if (IN(3)) {
        pg8::StaticOrder S; S.init(T, D, G, bx, -1);
        { pg8::Gemm g{AB, PAT, T, D, GW}; pg8::EpiGateA E{OUT, GT}; pg8::gemm_phase<pg8::EpiGateA>(lds, g, S, E); }
        { pg8::Gemm g{OB, PBT, T, D, AW}; pg8::EpiGateB E{OUT, GT, MG}; pg8::gemm_phase<pg8::EpiGateB>(lds, g, S, E); }
    }
    SEAM(3);

    if (IN(4)) {
        pg8::Gemm g{MG, WOT, T, D, D}; pg8::StaticOrder S; S.init(T, D, G, bx, -1);
        pg8::EpiResid E{X, OUT};
        pg8::gemm_phase<pg8::EpiResid>(lds, g, S, E);
    }
    SEAM(4);

    if (IN(5)) {
        LAS float* wrt = (LAS float*)lds;
        for (int i = tid; i < 4096; i += 512) { const int cc = i >> 2, e4 = (i & 3) * 4; const f32x4 w = *(const f32x4*)(args.in[11] + cc * 16 + e4);
            wrt[(e4 + 0) * 1024 + cc] = w[0]; wrt[(e4 + 1) * 1024 + cc] = w[1]; wrt[(e4 + 2) * 1024 + cc] = w[2]; wrt[(e4 + 3) * 1024 + cc] = w[3]; }
        __syncthreads();
        f32x4 gg[4];
#pragma unroll
        for (int j = 0; j < 4; ++j) gg[j] = *((const f32x4*)args.in[10] + lane + 64 * j);
        for (int row = gw; row < T; row += NGW) {
            f32x4 v[4]; float s = 0.f;
#pragma unroll
            for (int j = 0; j < 4; ++j) { v[j] = *((const f32x4*)(OUT + (size_t)row * D) + lane + 64 * j); s += (v[j].x * v[j].x + v[j].y * v[j].y) + (v[j].z * v[j].z + v[j].w * v[j].w); }
            const float r = 1.0f / sqrtf(wave_sum(s) * (1.0f / D) + EPS);
#pragma unroll
            for (int j = 0; j < 4; ++j) { v[j] = v[j] * r * gg[j]; u32x2 w; w.x = cvt_pk_bf16(v[j][0], v[j][1]); w.y = cvt_pk_bf16(v[j][2], v[j][3]); *((u32x2*)(HB + (size_t)row * D) + lane + 64 * j) = w; }
            float pe[16]; float mx = -INFINITY;
#pragma unroll
            for (int e = 0; e < 16; ++e) { float a = 0.f;
#pragma unroll
                for (int j = 0; j < 4; ++j) { const f32x4 w = *(const LAS f32x4*)(wrt + e * 1024 + 4 * lane + 256 * j); a += (v[j][0] * w[0] + v[j][1] * w[1]) + (v[j][2] * w[2] + v[j][3] * w[3]); }
                pe[e] = wave_sum(a); mx = fmaxf(mx, pe[e]); }
            float den = 0.f;
#pragma unroll
            for (int e = 0; e < 16; ++e) { pe[e] = __expf(pe[e] - mx); den += pe[e]; }
            const float inv = 1.0f / den; float mine = 0.f;
#pragma unroll
            for (int e = 0; e < 16; ++e) mine = (lane == e) ? pe[e] * inv : mine;
            if (lane < 16) AFF[((size_t)(row >> 12) * NE + lane) * SEQ + (row & (SEQ - 1))] = mine;
        }
    }
    SEAM(5);

    if (IN(6)) {
        for (int item = vcu; item < 256; item += G) {
            const int be = item >> 2, qtr = item & 3, b = be >> 4, e = be & 15;
            LAS int* wsum = (LAS int*)lds;
            LAS int* idxl = (LAS int*)(lds + 256);
            __syncthreads();
            unsigned v[8];
            { const float* ap = AFF + (size_t)be * SEQ + 8 * tid; const f32x4 a0 = *(const f32x4*)ap, a1 = *(const f32x4*)(ap + 4);
#pragma unroll
              for (int i = 0; i < 4; ++i) { v[i] = __float_as_uint(a0[i]); v[4 + i] = __float_as_uint(a1[i]); } }
            unsigned prefix = 0u;
            for (int bit = 30; bit >= 0; --bit) {
                const unsigned cand = prefix | (1u << bit); int cnt = 0;
#pragma unroll
                for (int i = 0; i < 8; ++i) cnt += (v[i] >= cand) ? 1 : 0;
                cnt = wave_sum_i(cnt);
                if (lane == 0) wsum[(bit & 1) * 8 + wave] = cnt;
                __syncthreads();
                int tot = 0;
#pragma unroll
                for (int w = 0; w < 8; ++w) tot += wsum[(bit & 1) * 8 + w];
                if (tot >= CAP) prefix = cand;
            }
            const unsigned tau = prefix;
            int cgt = 0, ceq = 0;
#pragma unroll
            for (int i = 0; i < 8; ++i) { cgt += (v[i] > tau) ? 1 : 0; ceq += (v[i] == tau) ? 1 : 0; }
            int sce = ceq;
#pragma unroll
            for (int o = 1; o < 64; o <<= 1) { const int y = __shfl_up(sce, o); if (lane >= o) sce += y; }
            const int wgt = wave_sum_i(cgt);
            if (lane == 63) wsum[16 + wave] = sce;
            if (lane == 0) wsum[24 + wave] = wgt;
            __syncthreads();
            int ngt = 0, eqbase = sce - ceq;
#pragma unroll
            for (int w = 0; w < 8; ++w) { ngt += wsum[24 + w]; eqbase += (w < wave) ? wsum[16 + w] : 0; }
            const int need = CAP - ngt;
            unsigned selm = 0u; int nsel = 0, er = eqbase;
#pragma unroll
            for (int i = 0; i < 8; ++i) { bool sel = v[i] > tau; if (v[i] == tau) { sel = er < need; ++er; } if (sel) { selm |= (1u << i); ++nsel; } }
            int scs = nsel;
#pragma unroll
            for (int o = 1; o < 64; o <<= 1) { const int y = __shfl_up(scs, o); if (lane >= o) scs += y; }
            if (lane == 63) wsum[32 + wave] = scs;
            __syncthreads();
            int slot = scs - nsel;
#pragma unroll
            for (int w = 0; w < 8; ++w) slot += (w < wave) ? wsum[32 + w] : 0;
            const bool wr_slot = (tid >> 7) == qtr;
#pragma unroll
            for (int i = 0; i < 8; ++i) { const int tok = 8 * tid + i; const bool sel = (selm >> i) & 1u;
                if (sel) { idxl[slot] = tok; if ((slot >> 7) == qtr) GATE[(size_t)(e * NB + b) * CAP + slot] = __uint_as_float(v[i]); }
                if (wr_slot) SLOT[((size_t)b * SEQ + tok) * NE + e] = sel ? (short)slot : (short)-1;
                if (sel) ++slot; }
            __syncthreads();
            for (int i = 0; i < 16; ++i) { const int sl = 128 * qtr + 16 * wave + i; const int tok = idxl[sl];
                const bf16_t* src = HB + ((size_t)b * SEQ + tok) * D; bf16_t* dst = XE + ((size_t)(e * NB + b) * CAP + sl) * D;
                const u32x4 a = *(const u32x4*)(src + 8 * lane), c2 = *(const u32x4*)(src + 512 + 8 * lane);
                *(u32x4*)(dst + 8 * lane) = a; *(u32x4*)(dst + 512 + 8 * lane) = c2; }
        }
    }
    SEAM(6);

    if (IN(7)) {
        pg8::Gemm g{XE, WGU, MROWS, 2 * EH, D}; pg8::StaticOrder S; S.init(MROWS, 2 * EH, G, bx, 3);
        pg8::EpiSwiGLU E{ACT};
        pg8::gemm_phase<pg8::EpiSwiGLU>(lds, g, S, E);
    }
    SEAM(7);

    if (IN(8)) {
        pg8::Gemm g{ACT, WDT, MROWS, D, EH}; pg8::StaticOrder S; S.init(MROWS, D, G, bx, 3);
        pg8::EpiDown E{YB, GATE};
        pg8::gemm_phase<pg8::EpiDown>(lds, g, S, E);
    }
    SEAM(8);

    if (IN(9)) {
        f32x4 gg[4];
#pragma unroll
        for (int j = 0; j < 4; ++j) gg[j] = *((const f32x4*)args.in[15] + lane + 64 * j);
        for (int row = gw; row < T; row += NGW) {
            const int b = row >> 12;
            f32x4 v[4];
#pragma unroll
            for (int j = 0; j < 4; ++j) v[j] = *((const f32x4*)(OUT + (size_t)row * D) + lane + 64 * j);
            const u32x4 s0 = *(const u32x4*)(SLOT + (size_t)row * NE), s1 = *(const u32x4*)(SLOT + (size_t)row * NE + 8);
#pragma unroll
            for (int e = 0; e < 16; ++e) { const unsigned w = (e < 8) ? s0[(e & 7) >> 1] : s1[(e & 7) >> 1]; int sl = (int)(short)((e & 1) ? (w >> 16) : (w & 0xffffu)); sl = __builtin_amdgcn_readfirstlane(sl);
                if (sl >= 0) { const bf16_t* yp = YB + ((size_t)(e * NB + b) * CAP + sl) * D + 4 * lane;
#pragma unroll
                    for (int j = 0; j < 4; ++j) { const u32x2 yw = *(const u32x2*)(yp + 256 * j); v[j][0] += bf_lo(yw.x); v[j][1] += bf_hi(yw.x); v[j][2] += bf_lo(yw.y); v[j][3] += bf_hi(yw.y); } } }
            float s = 0.f;
#pragma unroll
            for (int j = 0; j < 4; ++j) s += (v[j].x * v[j].x + v[j].y * v[j].y) + (v[j].z * v[j].z + v[j].w * v[j].w);
            const float r = 1.0f / sqrtf(wave_sum(s) * (1.0f / D) + EPS);
#pragma unroll
            for (int j = 0; j < 4; ++j) *((f32x4*)(OUT + (size_t)row * D) + lane + 64 * j) = v[j] * r * gg[j];
        }
    }
#undef IN
#undef SEAM
}

extern "C" void kernel_launch(void* const* d_in, const int* in_sizes, int n_in, void* d_out, int out_size, void* d_ws, size_t ws_size, hipStream_t stream) {
    static int grid = 0;
    if (grid == 0) {
        if (n_in != 16 || in_sizes[0] != T * D || out_size != T * D || ws_size < WS_END) { fprintf(stderr, "kernel_launch: unexpected shapes (n_in %d, in0 %d, out %d, ws %zu < %zu)\n", n_in, n_in > 0 ? in_sizes[0] : -1, out_size, ws_size, (size_t)WS_END); grid = -1; return; }
        int dev = 0, cus = 0, per_cu = 0;
        if (hipGetDevice(&dev) != hipSuccess || hipDeviceGetAttribute(&cus, hipDeviceAttributeMultiprocessorCount, dev) != hipSuccess) { grid = -1; return; }
        if (hipFuncSetAttribute((const void*)mk_fwd, hipFuncAttributeMaxDynamicSharedMemorySize, LDS_BYTES) != hipSuccess) { fprintf(stderr, "kernel_launch: hipFuncSetAttribute failed\n"); grid = -1; return; }
        if (hipOccupancyMaxActiveBlocksPerMultiprocessor(&per_cu, (const void*)mk_fwd, NWAVES * 64, LDS_BYTES) != hipSuccess || per_cu < 1) { fprintf(stderr, "kernel_launch: occupancy query says %d blocks/CU\n", per_cu); per_cu = 1; }
        (void)hipGetLastError();
        grid = cus;
    }
    if (grid < 0) return;
    (void)hipMemsetAsync((char*)d_ws + WS_CTL, 0, 1 * MiB, stream);
    Args a{};
    for (int i = 0; i < 16; ++i) a.in[i] = (const float*)d_in[i];
    a.out = (float*)d_out; a.ws = (unsigned char*)d_ws;
#if MK_MODE == 0
    for (int p = 0; p < NPH; ++p) { a.ph_lo = p; a.ph_hi = p + 1; hipLaunchKernelGGL(mk_fwd, dim3(grid), dim3(NWAVES * 64), LDS_BYTES, stream, a); }
#elif MK_MODE == 1
    a.ph_lo = 0; a.ph_hi = NPH;
    void* kargs[] = {&a};
    hipError_t e = hipLaunchCooperativeKernel((const void*)mk_fwd, dim3(grid), dim3(NWAVES * 64), kargs, LDS_BYTES, stream);
    if (e != hipSuccess) fprintf(stderr, "kernel_launch: cooperative launch failed: %s\n", hipGetErrorString(e));
#else
    a.ph_lo = 0; a.ph_hi = NPH;
    hipLaunchKernelGGL(mk_fwd, dim3(grid), dim3(NWAVES * 64), LDS_BYTES, stream, a);
#endif
}
```

```cpp
#include <hip/hip_runtime.h>
#include <hip/hip_cooperative_groups.h>
#include <cstdio>
#include <cstdint>

#ifndef MK_MODE
#define MK_MODE 2
#endif

#ifndef STAMP_AMP
#define STAMP_AMP 4
#endif
#ifndef STAMP_BLK
#define STAMP_BLK 0
#endif
#define LAS __attribute__((address_space(3)))
typedef unsigned short bf16_t;
typedef short bf16x8 __attribute__((ext_vector_type(8)));
typedef short s16x4 __attribute__((ext_vector_type(4)));
typedef float f32x2 __attribute__((ext_vector_type(2)));
typedef float f32x4 __attribute__((ext_vector_type(4)));
typedef float f32x16 __attribute__((ext_vector_type(16)));
typedef unsigned u32x2 __attribute__((ext_vector_type(2)));
typedef unsigned u32x4 __attribute__((ext_vector_type(4)));

constexpr int NB = 4, SEQ = 4096, T = NB * SEQ, D = 1024;
constexpr int GW = 512, AW = 512, NH = 8, HD = 64;
constexpr int INC = 2 * GW + 3 * AW + 2 * D;
constexpr int P1W = 2 * GW + 3 * AW;
constexpr int GTW = 2 * D;
constexpr int NE = 16, EH = 1024, CAP = 512;
constexpr int MROWS = NE * NB * CAP;
constexpr float EPS = 1e-6f;
constexpr float LOG2E = 1.4426950408889634f;
constexpr int NPH = 10;

constexpr size_t MiB = 1u << 20;
constexpr size_t WS_CTL = 0;
constexpr size_t WS_WSP = 1 * MiB;
constexpr size_t WS_GATE = 1 * MiB + 512 * 1024;
constexpr size_t WS_ROWTOK = 1 * MiB + 768 * 1024;
constexpr size_t WS_SLOT = 2 * MiB;
constexpr size_t WS_AFF = 3 * MiB;
constexpr size_t WS_PAT = 5 * MiB;
constexpr size_t WS_WOT = 7 * MiB;
constexpr size_t WS_WGU = 9 * MiB;
constexpr size_t WS_WDT = 73 * MiB;
constexpr size_t WS_P1 = 105 * MiB;
constexpr size_t WS_MG = 105 * MiB;
constexpr size_t WS_ACT = 105 * MiB;
constexpr size_t WS_Y = 169 * MiB;
constexpr size_t WS_GT = 185 * MiB;
constexpr size_t WS_H2 = 201 * MiB;
constexpr size_t WS_H = 249 * MiB;
constexpr size_t WS_A = 249 * MiB;
constexpr size_t WS_X1 = 249 * MiB;
constexpr size_t WS_END = 281 * MiB;
constexpr int SCR_STRIDE = 68;

__device__ __forceinline__ unsigned cvt_pk_bf16(float lo, float hi) { unsigned r; asm volatile("v_cvt_pk_bf16_f32 %0, %1, %2" : "=v"(r) : "v"(lo), "v"(hi)); return r; }
typedef __bf16 bf16x2_t __attribute__((ext_vector_type(2)));
__device__ __forceinline__ unsigned cvt_pk_fast(float lo, float hi) { const f32x2 v = {lo, hi}; const bf16x2_t b = __builtin_convertvector(v, bf16x2_t); return __builtin_bit_cast(unsigned, b); }
__device__ __forceinline__ float bf_lo(unsigned w) { return __uint_as_float(w << 16); }
__device__ __forceinline__ float bf_hi(unsigned w) { return __uint_as_float(w & 0xffff0000u); }
__device__ __forceinline__ float wave_sum(float v) {
#pragma unroll
    for (int o = 1; o < 64; o <<= 1) v += __shfl_xor(v, o);
    return v;
}
__device__ __forceinline__ int wave_sum_i(int v) {
#pragma unroll
    for (int o = 1; o < 64; o <<= 1) v += __shfl_xor(v, o);
    return v;
}
__device__ __forceinline__ float fast_sigmoid(float y) { return __builtin_amdgcn_rcpf(1.0f + __builtin_amdgcn_exp2f(-LOG2E * y)); }
__device__ __forceinline__ float gelu_tanh(float x) {
    const float z = 0.7978845608028654f * (x + 0.044715f * x * x * x);
    return x * __builtin_amdgcn_rcpf(1.0f + __builtin_amdgcn_exp2f(-2.0f * LOG2E * z));
}

namespace pg8 {
constexpr int BM = 256, BK = 64, HALF = 128, HTB = HALF * BK * 2, STAGE_BYTES = 8 * HTB, NXCD = 8, WGM = 8;
__host__ __device__ __forceinline__ int lds_byte(int r, int c) { const int st = (r >> 4) * 2 + (c >> 5), rr = r & 15, cc = c & 31, ob = rr * 64 + cc * 2; return st * 1024 + (ob ^ (((ob >> 9) & 1) << 5)); }
__host__ __device__ __forceinline__ void stage_rc(int b, int& R, int& C) { const int st = b / 1024, sb = b % 1024, swz = sb ^ (((sb >> 9) & 1) << 5); R = (st >> 1) * 16 + swz / 64; C = (st & 1) * 32 + (swz % 64) / 2; }
__host__ __device__ __forceinline__ int perm32(int rho) { const int n = rho >> 4, i = rho & 15; return 8 * (i >> 2) + 4 * n + (i & 3); }

struct Unit { int pm, pn; };
struct Gemm { const bf16_t* A; const bf16_t* Bt; int M, N, K; const int* rowtok; };

struct StaticOrder {
    int nM, nN, nwg, G, c, gsh, N, ibeg, iend;
    __device__ void init(int M, int N_, int G_, int c_, int gsh_, int ibeg_ = 0, int iend_ = 1 << 20) { nM = M / BM; nN = N_ / BM; nwg = nM * nN; G = G_; c = c_; gsh = gsh_; N = N_; ibeg = ibeg_; iend = iend_; }
    __device__ bool next(int i, Unit& u) const {
        if (i + ibeg >= iend) return false;
        const long L = (long)(i + ibeg) * G + c; if (L >= nwg) return false;
        int wgid = (int)L; { const int q = nwg / NXCD, r = nwg % NXCD, xcd = wgid % NXCD, off = wgid / NXCD; wgid = (xcd < r ? xcd * (q + 1) : r * (q + 1) + (xcd - r) * q) + off; }
        const int nig = WGM * nN, gid = wgid / nig, fm = gid * WGM, gsz = (nM - fm) < WGM ? (nM - fm) : WGM;
        u.pm = fm + ((wgid % nig) % gsz); u.pn = (wgid % nig) / gsz; return true;
    }
    __device__ __forceinline__ int brow(const Unit& u) const { return (gsh >= 0 ? (u.pm >> gsh) * N : 0) + u.pn * BM; }
};

template <class Epi, bool ALIGN_EPI = true, bool SP2 = true, bool GATHER = false>
__device__ __forceinline__ void gemm_phase(LAS unsigned char* lds, const Gemm g, const StaticOrder& S, const Epi& E) {
    static_assert(!GATHER || SP2, "the gathered A operand is implemented for the SP2 loop");
    const int tid = threadIdx.x, wid = __builtin_amdgcn_readfirstlane(tid >> 6), lane = tid & 63, wr = wid >> 2, wc = wid & 3, fr = lane & 15, fq = lane >> 4;
    const int K = g.K, nt = K / BK;
    unsigned voffA[2], voffB[2];
#pragma unroll
    for (int i = 0; i < 2; ++i) { int R, C; stage_rc(tid * 16 + i * 8192, R, C); const int Rb = Epi::PERM ? ((R & ~31) + perm32(R & 31)) : R;
        voffA[i] = (unsigned)(R * K + C) * 2u; voffB[i] = (unsigned)(Rb * K + C) * 2u; }
    const size_t kstep = (size_t)(BK * 2);
    const size_t hstep = (size_t)HALF * K * 2;
    const size_t tstep = 2 * hstep;
    const size_t rstep = (size_t)K * 2;
    const unsigned ldsw = (unsigned)wid * 1024u;
    const int aoff = lds_byte(wr * 64 + fr, fq * 8), boff = lds_byte(wc * 32 + fr, fq * 8);
#define PG8_SA(b, h) (((b) * 2 + (h)) * HTB)
#define PG8_SB(b, h) ((4 + (b) * 2 + (h)) * HTB)
#define PG8_STAGE(bufoff, gbase, voff) do { _Pragma("unroll") for (int _i = 0; _i < 2; ++_i) \
        __builtin_amdgcn_global_load_lds((const unsigned*)((const char*)(gbase) + (voff)[_i]), (LAS unsigned*)(lds + (bufoff) + ldsw + _i * 8192), 16, 0, 0); } while (0)
#define PG8_LDA(dst, b, h) do { _Pragma("unroll") for (int m = 0; m < 4; ++m) _Pragma("unroll") for (int k = 0; k < 2; ++k) dst[m][k] = *(const LAS bf16x8*)(lds + PG8_SA(b, h) + aoff + m * 2048 + k * 1024); } while (0)
#define PG8_LDB(dst, b, h) do { _Pragma("unroll") for (int n = 0; n < 2; ++n) _Pragma("unroll") for (int k = 0; k < 2; ++k) dst[n][k] = *(const LAS bf16x8*)(lds + PG8_SB(b, h) + boff + n * 2048 + k * 1024); } while (0)
#define PG8_MMA(ai, bj, At, Bt) do { __builtin_amdgcn_s_setprio(1); _Pragma("unroll") for (int m = 0; m < 4; ++m) _Pragma("unroll") for (int n = 0; n < 2; ++n) _Pragma("unroll") for (int k = 0; k < 2; ++k) \
        acc[ai][bj][m][n] = __builtin_amdgcn_mfma_f32_16x16x32_bf16(Bt[n][k], At[m][k], acc[ai][bj][m][n], 0, 0, 0); __builtin_amdgcn_s_setprio(0); } while (0)
#define PG8_WAIT_V(n) asm volatile("s_waitcnt vmcnt(" #n ")" ::: "memory")
#define PG8_WAIT_L(n) asm volatile("s_waitcnt lgkmcnt(" #n ")" ::: "memory")
#define PG8_BAR __builtin_amdgcn_s_barrier()
#define PG8_SCHED __builtin_amdgcn_sched_barrier(0)
    unsigned gAc[2][2], gAn[2][2];
#define PG8_GOFF(dst, u) do { if constexpr (GATHER) { _Pragma("unroll") for (int _h = 0; _h < 2; ++_h) _Pragma("unroll") for (int _i = 0; _i < 2; ++_i) { int R_, C_; stage_rc(tid * 16 + _i * 8192, R_, C_); \
        dst[_h][_i] = (unsigned)g.rowtok[(u).pm * BM + _h * HALF + R_] * (unsigned)(K * 2) + (unsigned)(C_ * 2); } } } while (0)
#define PG8_STAGEA(bufoff, SEL, H, KT) do { if constexpr (GATHER) { const char* _b = (const char*)g.A + (size_t)(KT) * kstep; \
        _Pragma("unroll") for (int _i = 0; _i < 2; ++_i) __builtin_amdgcn_global_load_lds((const unsigned*)(_b + ((SEL) ? gAn[H][_i] : gAc[H][_i])), (LAS unsigned*)(lds + (bufoff) + ldsw + _i * 8192), 16, 0, 0); } \
        else { const char* _b = ((SEL) ? nA : cA) + (size_t)(H) * hstep + (size_t)(KT) * kstep; PG8_STAGE(bufoff, _b, voffA); } } while (0)
    Unit cur, nxt; int ui = 0;
    if (!S.next(0, cur)) return;
    PG8_GOFF(gAc, cur);
    f32x4 acc[2][2][4][2];
#pragma unroll
    for (int a = 0; a < 2; ++a)
#pragma unroll
        for (int b = 0; b < 2; ++b)
#pragma unroll
            for (int m = 0; m < 4; ++m)
#pragma unroll
                for (int n = 0; n < 2; ++n) acc[a][b][m][n] = (f32x4){0.f, 0.f, 0.f, 0.f};
    bf16x8 At[4][2], B0[2][2], B1[2][2];
    const char* cA = (const char*)g.A + (size_t)cur.pm * tstep; const char* cB = (const char*)g.Bt + (size_t)S.brow(cur) * rstep;
    const char* nA = cA;
    if constexpr (SP2) {
        PG8_STAGE(PG8_SB(0, 0), cB, voffB); PG8_STAGE(PG8_SB(0, 1), cB + hstep, voffB); PG8_STAGEA(PG8_SA(0, 0), 0, 0, 0); PG8_STAGEA(PG8_SA(0, 1), 0, 1, 0);
        if (wr == 1) PG8_BAR;
        PG8_WAIT_V(2); PG8_BAR;
        PG8_STAGE(PG8_SB(1, 0), cB + kstep, voffB); PG8_STAGEA(PG8_SA(1, 0), 0, 0, 1); PG8_STAGE(PG8_SB(1, 1), cB + hstep + kstep, voffB);
        PG8_WAIT_V(6); PG8_BAR;
    } else {
        PG8_STAGE(PG8_SB(0, 0), cB, voffB); PG8_STAGE(PG8_SA(0, 0), cA, voffA); PG8_STAGE(PG8_SB(0, 1), cB + hstep, voffB); PG8_STAGE(PG8_SA(0, 1), cA + hstep, voffA);
        if (wr == 1) PG8_BAR;
        PG8_WAIT_V(4); PG8_BAR;
        PG8_STAGE(PG8_SB(1, 0), cB + kstep, voffB); PG8_STAGE(PG8_SA(1, 0), cA + kstep, voffA); PG8_STAGE(PG8_SB(1, 1), cB + hstep + kstep, voffB);
        PG8_WAIT_V(6); PG8_BAR;
    }
    for (;;) {
        const bool has_next = S.next(ui + 1, nxt);
        nA = has_next ? (const char*)g.A + (size_t)nxt.pm * tstep : cA; const char* nB = has_next ? (const char*)g.Bt + (size_t)S.brow(nxt) * rstep : cB;
        if constexpr (GATHER) { if (has_next) PG8_GOFF(gAn, nxt); else {
#pragma unroll
            for (int _h = 0; _h < 2; ++_h)
#pragma unroll
                for (int _i = 0; _i < 2; ++_i) gAn[_h][_i] = gAc[_h][_i]; } }
        for (int t = 0; t < nt; t += 2) {
            const bool last = (t == nt - 2);
            if constexpr (Epi::MIDK) { if (t == E.midt(nt)) E.mid(acc, cur, wr, wc, fr, fq); }
            const char* a1 = cA + (size_t)(t + 1) * kstep;
            const char* a2 = last ? nA : cA + (size_t)(t + 2) * kstep; const char* b2 = last ? nB : cB + (size_t)(t + 2) * kstep;
            const char* a3 = a2 + kstep; const char* b3 = b2 + kstep;
            if constexpr (SP2) {
            const int sel2 = last ? 1 : 0, kt2 = last ? 0 : t + 2;
            PG8_LDB(B0, 0, 0); PG8_LDB(B1, 0, 1); PG8_SCHED; PG8_LDA(At, 0, 0); PG8_STAGEA(PG8_SA(1, 1), 0, 1, t + 1);
            PG8_WAIT_V(8); PG8_WAIT_L(0); PG8_BAR; PG8_MMA(0, 0, At, B0); PG8_MMA(0, 1, At, B1); PG8_BAR; PG8_SCHED;
            PG8_LDA(At, 0, 1); PG8_STAGE(PG8_SB(0, 0), b2, voffB); PG8_STAGE(PG8_SB(0, 1), b2 + hstep, voffB); PG8_STAGEA(PG8_SA(0, 0), sel2, 0, kt2);
            PG8_WAIT_V(8); PG8_WAIT_L(0); PG8_BAR; PG8_MMA(1, 0, At, B0); PG8_MMA(1, 1, At, B1); PG8_BAR; PG8_SCHED;
            PG8_LDB(B0, 1, 0); PG8_LDB(B1, 1, 1); PG8_SCHED; PG8_LDA(At, 1, 0); PG8_STAGEA(PG8_SA(0, 1), sel2, 1, kt2);
            PG8_WAIT_V(8); PG8_WAIT_L(0); PG8_BAR; PG8_MMA(0, 0, At, B0); PG8_MMA(0, 1, At, B1); PG8_BAR; PG8_SCHED;
            PG8_LDA(At, 1, 1); PG8_STAGE(PG8_SB(1, 0), b3, voffB); PG8_STAGE(PG8_SB(1, 1), b3 + hstep, voffB); PG8_STAGEA(PG8_SA(1, 0), sel2, 0, kt2 + 1);
            PG8_WAIT_V(8); PG8_WAIT_L(0); PG8_BAR; PG8_MMA(1, 0, At, B0); PG8_MMA(1, 1, At, B1); PG8_BAR; PG8_SCHED;
            } else {
            PG8_LDB(B0, 0, 0); PG8_SCHED; PG8_LDA(At, 0, 0); PG8_STAGE(PG8_SA(1, 1), a1 + hstep, voffA);
            PG8_WAIT_L(8); PG8_BAR; PG8_WAIT_L(0); PG8_MMA(0, 0, At, B0); PG8_BAR; PG8_SCHED;
            PG8_LDB(B1, 0, 1); PG8_STAGE(PG8_SB(0, 0), b2, voffB);
            PG8_BAR; PG8_WAIT_L(0); PG8_MMA(0, 1, At, B1); PG8_BAR;
            PG8_LDA(At, 0, 1); PG8_STAGE(PG8_SA(0, 0), a2, voffA);
            PG8_BAR; PG8_WAIT_L(0); PG8_MMA(1, 0, At, B0); PG8_BAR; PG8_SCHED;
            PG8_STAGE(PG8_SB(0, 1), b2 + hstep, voffB);
            PG8_WAIT_V(6); PG8_BAR; PG8_MMA(1, 1, At, B1); PG8_BAR;
            PG8_LDB(B0, 1, 0); PG8_SCHED; PG8_LDA(At, 1, 0); PG8_STAGE(PG8_SA(0, 1), a2 + hstep, voffA);
            PG8_WAIT_L(8); PG8_BAR; PG8_WAIT_L(0); PG8_MMA(0, 0, At, B0); PG8_BAR; PG8_SCHED;
            PG8_LDB(B1, 1, 1); PG8_STAGE(PG8_SB(1, 0), b3, voffB);
            PG8_BAR; PG8_WAIT_L(0); PG8_MMA(0, 1, At, B1); PG8_BAR;
            PG8_LDA(At, 1, 1); PG8_STAGE(PG8_SA(1, 0), a3, voffA);
            PG8_BAR; PG8_WAIT_L(0); PG8_MMA(1, 0, At, B0); PG8_BAR; PG8_SCHED;
            PG8_STAGE(PG8_SB(1, 1), b3 + hstep, voffB);
            PG8_WAIT_V(6); PG8_BAR; PG8_MMA(1, 1, At, B1); PG8_BAR;
            }
        }
        if constexpr (ALIGN_EPI) { if (wr == 0) PG8_BAR; }
        E(acc, cur, wr, wc, fr, fq);
        if (!has_next) break;
#pragma unroll
        for (int a = 0; a < 2; ++a)
#pragma unroll
            for (int b = 0; b < 2; ++b)
#pragma unroll
                for (int m = 0; m < 4; ++m)
#pragma unroll
                    for (int n = 0; n < 2; ++n) acc[a][b][m][n] = (f32x4){0.f, 0.f, 0.f, 0.f};
        cur = nxt; cA = nA; cB = nB; ++ui;
        if constexpr (GATHER) {
#pragma unroll
            for (int _h = 0; _h < 2; ++_h)
#pragma unroll
                for (int _i = 0; _i < 2; ++_i) gAc[_h][_i] = gAn[_h][_i]; }
        if constexpr (ALIGN_EPI) { if (wr == 1) PG8_BAR; }
    }
    PG8_WAIT_V(0);
    if constexpr (!ALIGN_EPI) { if (wr == 0) PG8_BAR; }
    PG8_BAR;
#undef PG8_SA
#undef PG8_SB
#undef PG8_STAGE
#undef PG8_STAGEA
#undef PG8_GOFF
#undef PG8_LDA
#undef PG8_LDB
#undef PG8_MMA
#undef PG8_WAIT_V
#undef PG8_WAIT_L
#undef PG8_BAR
#undef PG8_SCHED
}

typedef const f32x4 (&AccRef)[2][2][4][2];
typedef f32x4 (&AccMut)[2][2][4][2];

struct EpiProj {
    static constexpr bool PERM = true, MIDK = false;
    bf16_t* P1; bf16_t* GT; const float* bgate;
    __device__ __forceinline__ void operator()(AccRef acc, const Unit& u, int wr, int wc, int fr, int fq) const {
        const int pn = u.pn, row0 = u.pm * BM + wr * 64 + fr, cl = wc * 32 + 8 * fq;
        const bool isg = pn >= 10;
        bf16_t* base = isg ? GT + (pn - 10) * 256 + cl : P1 + pn * 256 + cl;
        const int ldc = isg ? GTW : P1W;
        const int mode = isg ? 3 : (pn < 4 ? 1 : (pn < 6 ? 2 : 0));
        f32x4 bv[2][2];
#pragma unroll
        for (int bj = 0; bj < 2; ++bj)
#pragma unroll
            for (int n = 0; n < 2; ++n) bv[bj][n] = isg ? *(const f32x4*)(bgate + (pn - 10) * 256 + bj * HALF + cl + 4 * n) : (f32x4){0.f, 0.f, 0.f, 0.f};
#pragma unroll
        for (int ai = 0; ai < 2; ++ai)
#pragma unroll
            for (int m = 0; m < 4; ++m) { bf16_t* rowp = base + (size_t)(row0 + ai * HALF + m * 16) * ldc;
#pragma unroll
                for (int bj = 0; bj < 2; ++bj) { f32x4 v0 = acc[ai][bj][m][0], v1 = acc[ai][bj][m][1];
                    if (mode == 1) {
#pragma unroll
                        for (int j = 0; j < 4; ++j) { v0[j] = gelu_tanh(v0[j]); v1[j] = gelu_tanh(v1[j]); } }
                    else if (mode == 2) { v0 = v0 * (0.125f * LOG2E); v1 = v1 * (0.125f * LOG2E); }
                    else if (mode == 3) { v0 = v0 + bv[bj][0]; v1 = v1 + bv[bj][1];
#pragma unroll
                        for (int j = 0; j < 4; ++j) { v0[j] = fast_sigmoid(v0[j]); v1[j] = fast_sigmoid(v1[j]); } }
                    u32x4 w; w.x = cvt_pk_bf16(v0[0], v0[1]); w.y = cvt_pk_bf16(v0[2], v0[3]); w.z = cvt_pk_bf16(v1[0], v1[1]); w.w = cvt_pk_bf16(v1[2], v1[3]);
                    *(u32x4*)(rowp + bj * HALF) = w; } }
    }
};
struct EpiMerge {
    static constexpr bool PERM = true, MIDK = true;
    const bf16_t* GT; bf16_t* MG;
    __device__ __forceinline__ int midt(int nt) const { return nt / 2; }
    __device__ __forceinline__ void mid(AccMut acc, const Unit& u, int wr, int wc, int fr, int fq) const {
        asm volatile("" : "+v"(fr), "+v"(fq));
        const int row0 = u.pm * BM + wr * 64 + fr, col0 = u.pn * BM + wc * 32 + 8 * fq;
#pragma unroll
        for (int ai = 0; ai < 2; ++ai)
#pragma unroll
            for (int m = 0; m < 4; ++m) { const bf16_t* gp = GT + (size_t)(row0 + ai * HALF + m * 16) * GTW + col0;
#pragma unroll
                for (int bj = 0; bj < 2; ++bj) { const u32x4 ga = *(const u32x4*)(gp + bj * HALF), gb = *(const u32x4*)(gp + D + bj * HALF);
#pragma unroll
                    for (int j = 0; j < 2; ++j) { acc[ai][bj][m][0][2 * j] *= bf_lo(ga[j]) * __builtin_amdgcn_rcpf(fmaxf(bf_lo(gb[j]), 1e-18f)); acc[ai][bj][m][0][2 * j + 1] *= bf_hi(ga[j]) * __builtin_amdgcn_rcpf(fmaxf(bf_hi(gb[j]), 1e-18f));
                        acc[ai][bj][m][1][2 * j] *= bf_lo(ga[2 + j]) * __builtin_amdgcn_rcpf(fmaxf(bf_lo(gb[2 + j]), 1e-18f)); acc[ai][bj][m][1][2 * j + 1] *= bf_hi(ga[2 + j]) * __builtin_amdgcn_rcpf(fmaxf(bf_hi(gb[2 + j]), 1e-18f)); } }
                if (m == 3) asm volatile("" ::: "memory"); }
    }
    __device__ __forceinline__ void operator()(AccRef acc, const Unit& u, int wr, int wc, int fr, int fq) const {
        const int row0 = u.pm * BM + wr * 64 + fr, col0 = u.pn * BM + wc * 32 + 8 * fq;
#pragma unroll
        for (int ai = 0; ai < 2; ++ai)
#pragma unroll
            for (int m = 0; m < 4; ++m) { const size_t r = (size_t)(row0 + ai * HALF + m * 16);
#pragma unroll
                for (int bj = 0; bj < 2; ++bj) { const u32x4 gb = *(const u32x4*)(GT + r * GTW + D + col0 + bj * HALF); const f32x4 v0 = acc[ai][bj][m][0], v1 = acc[ai][bj][m][1];
                    u32x4 w; w.x = cvt_pk_bf16(v0[0] * fmaxf(bf_lo(gb[0]), 1e-18f), v0[1] * fmaxf(bf_hi(gb[0]), 1e-18f)); w.y = cvt_pk_bf16(v0[2] * fmaxf(bf_lo(gb[1]), 1e-18f), v0[3] * fmaxf(bf_hi(gb[1]), 1e-18f));
                    w.z = cvt_pk_bf16(v1[0] * fmaxf(bf_lo(gb[2]), 1e-18f), v1[1] * fmaxf(bf_hi(gb[2]), 1e-18f)); w.w = cvt_pk_bf16(v1[2] * fmaxf(bf_lo(gb[3]), 1e-18f), v1[3] * fmaxf(bf_hi(gb[3]), 1e-18f));
                    *(u32x4*)(MG + r * D + col0 + bj * HALF) = w; } }
    }
};
struct EpiResid {
    static constexpr bool PERM = false, MIDK = false;
    const float* X; bf16_t* X1;
    __device__ __forceinline__ void operator()(AccRef acc, const Unit& u, int wr, int wc, int fr, int fq) const {
        const int row0 = u.pm * BM + wr * 64 + fr, col0 = u.pn * BM + wc * 32 + 4 * fq;
#pragma unroll
        for (int ai = 0; ai < 2; ++ai)
#pragma unroll
            for (int m = 0; m < 4; ++m) { const size_t r = (size_t)(row0 + ai * HALF + m * 16);
#pragma unroll
                for (int bj = 0; bj < 2; ++bj)
#pragma unroll
                    for (int n = 0; n < 2; ++n) { const int c = col0 + bj * HALF + n * 16;
                        const f32x4 o = *(const f32x4*)(X + r * D + c) + acc[ai][bj][m][n];
                        u32x2 w; w.x = cvt_pk_bf16(o[0], o[1]); w.y = cvt_pk_bf16(o[2], o[3]); *(u32x2*)(X1 + r * D + c) = w; } }
    }
};
struct EpiSwiGLU {
    static constexpr bool PERM = true, MIDK = false;
    bf16_t* ACT;
    __device__ __forceinline__ void operator()(AccRef acc, const Unit& u, int wr, int wc, int fr, int fq) const {
        const int row0 = u.pm * BM + wr * 64 + fr, col0 = u.pn * HALF + wc * 32 + 8 * fq;
#pragma unroll
        for (int ai = 0; ai < 2; ++ai)
#pragma unroll
            for (int m = 0; m < 4; ++m) { bf16_t* rowp = ACT + (size_t)(row0 + ai * HALF + m * 16) * EH + col0;
                f32x4 o[2];
#pragma unroll
                for (int n = 0; n < 2; ++n) { const f32x4 gg = acc[ai][0][m][n], uu = acc[ai][1][m][n];
#pragma unroll
                    for (int j = 0; j < 4; ++j) o[n][j] = gg[j] * fast_sigmoid(gg[j]) * uu[j]; }
                u32x4 w; w.x = cvt_pk_bf16(o[0][0], o[0][1]); w.y = cvt_pk_bf16(o[0][2], o[0][3]); w.z = cvt_pk_bf16(o[1][0], o[1][1]); w.w = cvt_pk_bf16(o[1][2], o[1][3]);
                *(u32x4*)rowp = w; }
    }
};
struct EpiDown {
    static constexpr bool PERM = true, MIDK = false;
    bf16_t* Y; const float* gate;
    __device__ __forceinline__ void operator()(AccRef acc, const Unit& u, int wr, int wc, int fr, int fq) const {
        const int row0 = u.pm * BM + wr * 64 + fr, col0 = u.pn * BM + wc * 32 + 8 * fq;
#pragma unroll
        for (int ai = 0; ai < 2; ++ai)
#pragma unroll
            for (int m = 0; m < 4; ++m) { const int r = row0 + ai * HALF + m * 16; const float gt = gate[r]; bf16_t* rowp = Y + (size_t)r * D + col0;
#pragma unroll
                for (int bj = 0; bj < 2; ++bj) { const f32x4 v0 = acc[ai][bj][m][0] * gt, v1 = acc[ai][bj][m][1] * gt;
                    u32x4 w; w.x = cvt_pk_bf16(v0[0], v0[1]); w.y = cvt_pk_bf16(v0[2], v0[3]); w.z = cvt_pk_bf16(v1[0], v1[1]); w.w = cvt_pk_bf16(v1[2], v1[3]);
                    *(u32x4*)(rowp + bj * HALF) = w; } }
    }
};
}

#define XB_TMO      128
#define XB_XCNT(j)  (256  + 64 * (j))
#define XB_XSUB(j)  (1280 + 64 * (j))
#define XB_XGEN(j)  (2304 + 64 * (j))
#define XB_TOP      3328
#define XB_TOPGEN   3392
#define XCD_BAR_WORDS 3456
#define XB_SPIN_CAP (1u << 18)
__device__ __forceinline__ unsigned xb_ld(unsigned* p)              { return __hip_atomic_load(p, __ATOMIC_RELAXED, __HIP_MEMORY_SCOPE_AGENT); }
__device__ __forceinline__ unsigned xb_add(unsigned* p, unsigned v) { return __hip_atomic_fetch_add(p, v, __ATOMIC_RELAXED, __HIP_MEMORY_SCOPE_AGENT); }
__device__ __forceinline__ unsigned xb_xcc_id() { return (unsigned)__builtin_amdgcn_s_getreg((3 << 11) | 20) & 0xFu; }
#define XB_SPIN(cond, bar) do { unsigned _sp = 0; while (cond) { __builtin_amdgcn_s_sleep(1); \
    if ((++_sp & 255u) == 0u) { if (xb_ld(&(bar)[XB_TMO])) break; if (_sp > XB_SPIN_CAP) { atomicAdd(&(bar)[XB_TMO], 1u); break; } } } } while (0)
struct XcdBarrier { unsigned* bar; unsigned x; volatile LAS unsigned* st; };
__device__ __forceinline__ XcdBarrier xcd_barrier_post(unsigned* bar, volatile LAS unsigned* st) {
    XcdBarrier b; b.bar = bar; b.x = xb_xcc_id(); b.st = st;
    if (threadIdx.x == 0) (void)xb_add(&bar[XB_XCNT(b.x)], 1u);
    return b;
}
__device__ __forceinline__ void xcd_barrier_complete(unsigned* bar, unsigned x, unsigned& nloc, unsigned& nx) {
    const unsigned G = gridDim.x * gridDim.y * gridDim.z;
    unsigned sum, cnt, mine, sp = 0u;
    for (;;) {
        sum = 0u; cnt = 0u; mine = 0u;
#pragma unroll
        for (unsigned j = 0; j < 16; ++j) { const unsigned c = xb_ld(&bar[XB_XCNT(j)]); sum += c; cnt += (c > 0u) ? 1u : 0u; mine = (j == x) ? c : mine; }
        if (sum == G) break;
        __builtin_amdgcn_s_sleep(1);
        if ((++sp & 255u) == 0u) { if (xb_ld(&bar[XB_TMO])) break; if (sp > XB_SPIN_CAP) { atomicAdd(&bar[XB_TMO], 1u); break; } }
    }
    nloc = mine > 0u ? mine : 1u; nx = cnt > 0u ? cnt : 1u;
}
__device__ __forceinline__ void xcd_barrier(const XcdBarrier& b) {
    asm volatile("s_waitcnt vmcnt(0)" ::: "memory");
    __syncthreads();
    if (threadIdx.x == 0) {
        unsigned* bar = b.bar;
        __builtin_amdgcn_s_waitcnt(0);
        unsigned nloc = b.st[0], nx = b.st[1];
        if (nloc == 0u) { xcd_barrier_complete(bar, b.x, nloc, nx); b.st[0] = nloc; b.st[1] = nx; }
        const unsigned old = xb_add(&bar[XB_XSUB(b.x)], 1u);
        const unsigned gen = old / nloc;
        if (old + 1u == (gen + 1u) * nloc) {
            __builtin_amdgcn_fence(__ATOMIC_RELEASE, "agent");
            asm volatile("s_waitcnt vmcnt(0)" ::: "memory");
            const unsigned og = xb_add(&bar[XB_TOP], 1u);
            const unsigned tg = og / nx;
            if (og + 1u == (tg + 1u) * nx) xb_add(&bar[XB_TOPGEN], 1u);
            else XB_SPIN(xb_ld(&bar[XB_TOPGEN]) == tg, bar);
            __builtin_amdgcn_fence(__ATOMIC_ACQUIRE, "agent");
            xb_add(&bar[XB_XGEN(b.x)], 1u);
            asm volatile("s_waitcnt vmcnt(0)" ::: "memory");
        } else {
            XB_SPIN(xb_ld(&bar[XB_XGEN(b.x)]) == gen, bar);
            __builtin_amdgcn_fence(__ATOMIC_ACQUIRE, "agent");
            asm volatile("s_waitcnt vmcnt(0)" ::: "memory");
        }
    }
    __syncthreads();
}

constexpr int NWAVES = 8;
constexpr int LDS_BYTES = 147456;
constexpr int MISC_OFF = 144 * 1024 - 256;
constexpr int CW_BAR = 4096;

struct Args { const float* in[16]; float* out; unsigned char* ws; int ph_lo, ph_hi; };

struct TileRegs { f32x4 v[16]; };
__device__ __forceinline__ void tile_load(TileRegs& t, const float* W, int N, int k0, int n0, int lane) {
    const int n4 = (lane & 15) * 4, kq = lane >> 4;
#pragma unroll
    for (int i = 0; i < 16; ++i) t.v[i] = __builtin_nontemporal_load((const f32x4*)(W + (size_t)(k0 + 4 * i + kq) * N + n0 + n4));
}
__device__ __forceinline__ void tile_store(const TileRegs& t, int k0, bf16_t* WT, int Kd, int drow0, LAS float* scr, int lane) {
    const int n4 = (lane & 15) * 4, kq = lane >> 4;
#pragma unroll
    for (int i = 0; i < 16; ++i) { LAS float* s = scr + (4 * i + kq) * 65 + n4; s[0] = t.v[i][0]; s[1] = t.v[i][1]; s[2] = t.v[i][2]; s[3] = t.v[i][3]; }
    asm volatile("s_waitcnt lgkmcnt(0)" ::: "memory");
    const int c = lane & 7;
#pragma unroll
    for (int jj = 0; jj < 8; ++jj) { const int n = (lane >> 3) + 8 * jj; const LAS float* s = scr + (8 * c) * 65 + n;
        u32x4 o; o.x = cvt_pk_fast(s[0], s[65]); o.y = cvt_pk_fast(s[2 * 65], s[3 * 65]); o.z = cvt_pk_fast(s[4 * 65], s[5 * 65]); o.w = cvt_pk_fast(s[6 * 65], s[7 * 65]);
        __builtin_nontemporal_store(o, (u32x4*)(WT + (size_t)(drow0 + n) * Kd + k0 + 8 * c)); }
    asm volatile("s_waitcnt lgkmcnt(0)" ::: "memory");
}
__device__ __forceinline__ void transpose_tile(const float* W, int N, int k0, int n0, bf16_t* WT, int Kd, int drow0, LAS float* scr, int lane) {
    TileRegs t; tile_load(t, W, N, k0, n0, lane); tile_store(t, k0, WT, Kd, drow0, scr, lane);
}
struct ExTile { const float* W; int N, k0, n0; bf16_t* WT; int Kd, drow0; };
__device__ __forceinline__ ExTile expert_tile(int it, const float* wg, const float* wu, const float* wd, bf16_t* WGU, bf16_t* WDT) {
    const int e = it / 768, q = it % 768, kind = q / 256, t = q % 256, k0 = 64 * (t / 16), n0 = 64 * (t % 16);
    ExTile x; x.k0 = k0; x.n0 = n0;
    if (kind < 2) { x.W = (kind == 0 ? wg : wu) + (size_t)e * D * EH; x.N = EH; x.WT = WGU + (size_t)e * 2048 * D; x.Kd = D; x.drow0 = 256 * (n0 >> 7) + 128 * kind + (n0 & 127); }
    else { x.W = wd + (size_t)e * EH * D; x.N = D; x.WT = WDT + (size_t)e * D * EH; x.Kd = EH; x.drow0 = n0; }
    return x;
}
__device__ __forceinline__ void rms_regs_to_bf16(const f32x4 (&v)[4], const f32x4 (&gg)[4], bf16_t* orow, int lane) {
    float s = 0.f;
#pragma unroll
    for (int j = 0; j < 4; ++j) s += (v[j].x * v[j].x + v[j].y * v[j].y) + (v[j].z * v[j].z + v[j].w * v[j].w);
    const float r = 1.0f / sqrtf(wave_sum(s) * (1.0f / D) + EPS);
#pragma unroll
    for (int j = 0; j < 4; ++j) { const f32x4 o = v[j] * r * gg[j]; u32x2 w; w.x = cvt_pk_bf16(o[0], o[1]); w.y = cvt_pk_bf16(o[2], o[3]); *((u32x2*)orow + lane + 64 * j) = w; }
}

__device__ __forceinline__ s16x4 tr_read(const LAS unsigned char* p) {
    typedef short v4i16_t __attribute__((ext_vector_type(4)));
    return __builtin_bit_cast(s16x4, __builtin_amdgcn_ds_read_tr16_b64_v4i16((LAS v4i16_t*)p));
}

__global__ void __launch_bounds__(NWAVES * 64, 2) mk_fwd(Args args) {
    extern __shared__ __attribute__((aligned(16))) unsigned char lds_raw[];
    LAS unsigned char* lds = (LAS unsigned char*)lds_raw;
    const int tid = threadIdx.x, lane = tid & 63, wave = __builtin_amdgcn_readfirstlane(tid >> 6);
    const int G = gridDim.x, bx = blockIdx.x;
    const int vcu = (G % 8 == 0) ? (bx % 8) * (G / 8) + bx / 8 : bx;
    const int gw = vcu * NWAVES + wave, NGW = G * NWAVES;
    unsigned char* ws = args.ws;
    float* OUT = args.out;
    const float* X = args.in[0];
    bf16_t* WSP = (bf16_t*)(ws + WS_WSP); float* GATE = (float*)(ws + WS_GATE); int* ROWTOK = (int*)(ws + WS_ROWTOK); short* SLOT = (short*)(ws + WS_SLOT); float* AFF = (float*)(ws + WS_AFF);
    bf16_t* PAT = (bf16_t*)(ws + WS_PAT); bf16_t* WOT = (bf16_t*)(ws + WS_WOT);
    bf16_t* WGU = (bf16_t*)(ws + WS_WGU); bf16_t* WDT = (bf16_t*)(ws + WS_WDT);
    bf16_t* P1 = (bf16_t*)(ws + WS_P1); bf16_t* MG = (bf16_t*)(ws + WS_MG); bf16_t* YB = (bf16_t*)(ws + WS_Y); bf16_t* H2 = (bf16_t*)(ws + WS_H2); bf16_t* X1B = (bf16_t*)(ws + WS_X1);
    bf16_t* ACT = (bf16_t*)(ws + WS_ACT); bf16_t* GT = (bf16_t*)(ws + WS_GT);
    bf16_t* HB = (bf16_t*)(ws + WS_H); bf16_t* AB = (bf16_t*)(ws + WS_A);
    bf16_t* WIT = (bf16_t*)OUT;
    float* SCR = OUT;

#if MK_MODE == 2
    volatile LAS unsigned* MISC = (volatile LAS unsigned*)(lds + MISC_OFF);
    if (tid < 64) MISC[tid] = 0u;
    __syncthreads();
    XcdBarrier bar = xcd_barrier_post((unsigned*)(ws + WS_CTL) + CW_BAR, MISC + 8);
#define GRID_BAR() xcd_barrier(bar)
#elif MK_MODE == 1
#define GRID_BAR() cooperative_groups::this_grid().sync()
#else
#define GRID_BAR() do {} while (0)
#endif
#ifdef STAMP_LO
    unsigned long long ts0 = 0, ts1 = 0;
#define STAMP_AT(k) do { if ((k) == STAMP_LO) ts0 = __builtin_amdgcn_s_memrealtime(); if ((k) == STAMP_HI) ts1 = __builtin_amdgcn_s_memrealtime(); } while (0)
#else
#define STAMP_AT(k) do {} while (0)
#endif
    const int lo = args.ph_lo, hi = args.ph_hi;
#define IN(k) (lo <= (k) && (k) < hi)
#define SEAM(k) do { if (IN(k) && IN((k) + 1)) GRID_BAR(); } while (0)

    STAMP_AT(0);
    if (IN(0)) {
        LAS float* scr = (LAS float*)(lds + wave * 16640);
        constexpr int I_IN = 16 * 72, I_PA = 8 * 16, I_WO = 16 * 16, I_EX = 16 * 16;
        constexpr int NITEMS = I_IN + 2 * I_PA + I_WO;
        (void)I_EX;
        for (int it = gw; it < NITEMS; it += NGW) {
            int r = it;
            if (r < I_IN) { transpose_tile(args.in[2], INC, 64 * (r / 72), 64 * (r % 72), WIT, D, 64 * (r % 72), scr, lane); continue; } r -= I_IN;
            if (r < I_PA) { transpose_tile(args.in[7], D, 64 * (r / 16), 64 * (r % 16), PAT, D, 64 * (r % 16), scr, lane); continue; } r -= I_PA;
            if (r < I_PA) { transpose_tile(args.in[8], D, 64 * (r / 16), 64 * (r % 16), PAT + GW, D, 64 * (r % 16), scr, lane); continue; } r -= I_PA;
            transpose_tile(args.in[9], D, 64 * (r / 16), 64 * (r % 16), WOT, D, 64 * (r % 16), scr, lane);
        }
        { const float* wsrc = args.in[5];
          for (int i = (vcu * 512 + tid) * 4; i < 8 * 128 * 128; i += G * 512 * 4) { const f32x4 v = *(const f32x4*)(wsrc + i); u32x2 w; w.x = cvt_pk_bf16(v[0], v[1]); w.y = cvt_pk_bf16(v[2], v[3]); *(u32x2*)(WSP + i) = w; } }
        f32x4 gg[4];
#pragma unroll
        for (int j = 0; j < 4; ++j) gg[j] = *((const f32x4*)args.in[1] + lane + 64 * j);
        { f32x4 cur[4];
#pragma unroll
          for (int j = 0; j < 4; ++j) cur[j] = __builtin_nontemporal_load((const f32x4*)(X + (size_t)gw * D) + lane + 64 * j);
          for (int m = gw; m < T; m += NGW) { f32x4 nx[4]; const int mn = (m + NGW < T) ? m + NGW : m;
#pragma unroll
            for (int j = 0; j < 4; ++j) nx[j] = __builtin_nontemporal_load((const f32x4*)(X + (size_t)mn * D) + lane + 64 * j);
            rms_regs_to_bf16(cur, gg, HB + (size_t)m * D, lane);
#pragma unroll
            for (int j = 0; j < 4; ++j) cur[j] = nx[j]; } }
    }
    SEAM(0);

    STAMP_AT(1);
    if (IN(1)) {
        const bool full5 = (G == 256) ? (bx < 128) : true;
        const int ncv = (G == 256) ? (full5 ? 32 : 64) : (12288 + G - 1) / G, cv0 = (G == 256) ? (full5 ? bx * 32 : 128 * 32 + (bx - 128) * 64) : bx * ncv;
        const int cvsplit = (bx >> 3) & 3;
#define CONVERT_EXPERTS() do { LAS float* scr = (LAS float*)(lds + wave * 16640); const int itend = (cv0 + ncv < 12288) ? cv0 + ncv : 12288; \
            int it = cv0 + wave; TileRegs tr; ExTile xt; \
            if (it < itend) { xt = expert_tile(it, args.in[12], args.in[13], args.in[14], WGU, WDT); tile_load(tr, xt.W, xt.N, xt.k0, xt.n0, lane); } \
            while (it < itend) { const ExTile xc = xt; const TileRegs tc = tr; it += NWAVES; \
                if (it < itend) { xt = expert_tile(it, args.in[12], args.in[13], args.in[14], WGU, WDT); tile_load(tr, xt.W, xt.N, xt.k0, xt.n0, lane); } \
                tile_store(tc, xc.k0, xc.WT, xc.Kd, xc.drow0, scr, lane); } \
            __syncthreads(); } while (0)
        pg8::Gemm g{HB, WIT, T, INC, D, nullptr}; pg8::EpiProj E{P1, GT, args.in[3]};
        if (cvsplit > 0) { pg8::StaticOrder S; S.init(T, INC, G, bx, -1, 0, cvsplit); pg8::gemm_phase<pg8::EpiProj>(lds, g, S, E); }
        STAMP_AT(110);
        CONVERT_EXPERTS();
        STAMP_AT(111);
        if (cvsplit < 5) { pg8::StaticOrder S; S.init(T, INC, G, bx, -1, cvsplit, 1 << 20); pg8::gemm_phase<pg8::EpiProj>(lds, g, S, E); }
#undef CONVERT_EXPERTS
    }
    STAMP_AT(114);
    SEAM(1);

    STAMP_AT(2);
    if (IN(2)) {
        for (int item = vcu; item < NB * NH * 8; item += G) {
            const int bh = item >> 3, blk = item & 7, b = bh >> 3, hd = bh & 7, Q0 = blk * 512;
            const float slope2 = __builtin_amdgcn_exp2f(-(float)(hd + 1)) * LOG2E;
            const bf16_t* qp = P1 + (size_t)b * SEQ * P1W + 1024 + 64 * hd; const bf16_t* kp = qp + 512; const bf16_t* vp = qp + 1024;
            LAS unsigned char* Kt = lds + wave * 10752; LAS unsigned char* Vt = Kt + 4608;
            const int c = lane & 31, h = lane >> 5, gi = lane & 15, g1 = (lane >> 4) & 1;
            float* scrI = SCR + (size_t)item * (512 * SCR_STRIDE);
            for (int pi = 0; pi < 3; ++pi) {
                const int dls = 4 - 2 * pi, nseq = SEQ >> dls;
                const float pen = slope2 * (float)(1 << dls);
                for (int uu = 0; uu < 2; ++uu) {
                    const int u = wave + 8 * uu, ql = 4 - dls, r = u >> ql, qt = u & ((1 << ql) - 1);
                    const int nq0 = (Q0 >> dls) + 32 * qt, tq = r + ((nq0 + c) << dls), qi = tq - Q0, nb = nq0 - 64;
                    bf16x8 qf[4];
                    { const bf16_t* qrow = qp + (size_t)tq * P1W + 8 * h;
#pragma unroll
                      for (int ks = 0; ks < 4; ++ks) qf[ks] = *(const bf16x8*)(qrow + 16 * ks); }
                    f32x16 o0, o1; float m, l;
                    float* sp = scrI + (size_t)qi * SCR_STRIDE;
                    if (pi == 0) {
#pragma unroll
                        for (int i = 0; i < 16; ++i) { o0[i] = 0.f; o1[i] = 0.f; }
                        m = -1e30f; l = 0.f;
                    } else {
#pragma unroll
                        for (int rg = 0; rg < 4; ++rg) { const f32x4 a = *(const f32x4*)(sp + 8 * rg + 4 * h), bq = *(const f32x4*)(sp + 32 + 8 * rg + 4 * h);
#pragma unroll
                            for (int j = 0; j < 4; ++j) { o0[4 * rg + j] = a[j]; o1[4 * rg + j] = bq[j]; } }
                        m = sp[64]; l = sp[65];
                    }
                    float pb[16];
#pragma unroll
                    for (int i = 0; i < 16; ++i) pb[i] = pen * (float)((i & 3) + 8 * (i >> 2) + 4 * h - c);
                    const bool edge = (nb < 0) || (nb + 160 > nseq);
                    u32x4 kr[4], vr[4];
#define ATT_LOAD(kt) do { _Pragma("unroll") for (int it = 0; it < 4; ++it) { int nk = nb + 32 * (kt) + (lane >> 3) + 8 * it; nk = nk < 0 ? 0 : (nk > nseq - 1 ? nseq - 1 : nk); \
                        const size_t off = (size_t)(r + (nk << dls)) * P1W + 8 * (lane & 7); kr[it] = *(const u32x4*)(kp + off); vr[it] = *(const u32x4*)(vp + off); } } while (0)
                    ATT_LOAD(0);
#pragma unroll
                    for (int kt = 0; kt < 5; ++kt) {
#pragma unroll
                        for (int it = 0; it < 4; ++it) { const int row = (lane >> 3) + 8 * it; *(LAS u32x4*)(Kt + row * 144 + 16 * (lane & 7)) = kr[it]; *(LAS u32x4*)(Vt + row * 192 + 16 * (lane & 7)) = vr[it]; }
                        if (kt < 4) ATT_LOAD(kt + 1);
                        f32x16 s;
#pragma unroll
                        for (int i = 0; i < 16; ++i) s[i] = 0.f;
#pragma unroll
                        for (int ks = 0; ks < 4; ++ks) { const bf16x8 kf = *(const LAS bf16x8*)(Kt + c * 144 + 32 * ks + 16 * h); s = __builtin_amdgcn_mfma_f32_32x32x16_bf16(kf, qf[ks], s, 0, 0, 0); }
                        const float cst = pen * (float)(32 * kt - 64);
#pragma unroll
                        for (int i = 0; i < 16; ++i) {
                            if (kt < 2) s[i] = s[i] + (pb[i] + cst); else if (kt == 2) s[i] = s[i] - __builtin_fabsf(pb[i]); else s[i] = s[i] - (pb[i] + cst);
                            if (kt == 0) s[i] = (pb[i] >= 0.f) ? s[i] : -INFINITY;
                            if (kt == 4) s[i] = (pb[i] <= 0.f) ? s[i] : -INFINITY; }
                        if (edge) {
#pragma unroll
                            for (int i = 0; i < 16; ++i) { const int nk = nb + 32 * kt + (i & 3) + 8 * (i >> 2) + 4 * h; s[i] = (nk >= 0 && nk < nseq) ? s[i] : -INFINITY; } }
                        float mx = fmaxf(fmaxf(s[0], s[1]), fmaxf(s[2], s[3]));
#pragma unroll
                        for (int i = 4; i < 16; i += 4) mx = fmaxf(mx, fmaxf(fmaxf(s[i], s[i + 1]), fmaxf(s[i + 2], s[i + 3])));
                        mx = fmaxf(mx, __shfl_xor(mx, 32));
                        const float mn = fmaxf(m, mx), alpha = __builtin_amdgcn_exp2f(m - mn);
                        float rs = 0.f;
#pragma unroll
                        for (int i = 0; i < 16; ++i) { s[i] = __builtin_amdgcn_exp2f(s[i] - mn); rs += s[i]; }
                        rs += __shfl_xor(rs, 32);
                        l = l * alpha + rs;
                        if (__any(mn > m)) {
#pragma unroll
                            for (int i = 0; i < 16; ++i) { o0[i] *= alpha; o1[i] *= alpha; } }
                        m = mn;
                        bf16x8 pf[2];
#pragma unroll
                        for (int s2 = 0; s2 < 2; ++s2) { const unsigned w0 = cvt_pk_bf16(s[8 * s2 + 0], s[8 * s2 + 1]), w1 = cvt_pk_bf16(s[8 * s2 + 2], s[8 * s2 + 3]), w2 = cvt_pk_bf16(s[8 * s2 + 4], s[8 * s2 + 5]), w3 = cvt_pk_bf16(s[8 * s2 + 6], s[8 * s2 + 7]);
                            pf[s2] = __builtin_bit_cast(bf16x8, (u32x4){w0, w1, w2, w3}); }
#pragma unroll
                        for (int s2 = 0; s2 < 2; ++s2)
#pragma unroll
                            for (int dt = 0; dt < 2; ++dt) { const LAS unsigned char* vb = Vt + (16 * s2 + 4 * h + (gi >> 2)) * 192 + (32 * dt + 16 * g1 + 4 * (gi & 3)) * 2;
                                const s16x4 vlo = tr_read(vb), vhi = tr_read(vb + 8 * 192);
                                const bf16x8 vf = (bf16x8){vlo[0], vlo[1], vlo[2], vlo[3], vhi[0], vhi[1], vhi[2], vhi[3]};
                                if (dt == 0) o0 = __builtin_amdgcn_mfma_f32_32x32x16_bf16(vf, pf[s2], o0, 0, 0, 0); else o1 = __builtin_amdgcn_mfma_f32_32x32x16_bf16(vf, pf[s2], o1, 0, 0, 0); }
                    }
#undef ATT_LOAD
                    if (pi < 2) {
#pragma unroll
                        for (int rg = 0; rg < 4; ++rg) { *(f32x4*)(sp + 8 * rg + 4 * h) = (f32x4){o0[4 * rg], o0[4 * rg + 1], o0[4 * rg + 2], o0[4 * rg + 3]};
                            *(f32x4*)(sp + 32 + 8 * rg + 4 * h) = (f32x4){o1[4 * rg], o1[4 * rg + 1], o1[4 * rg + 2], o1[4 * rg + 3]}; }
                        if (h == 0) { sp[64] = m; sp[65] = l; }
                    } else {
                        const float inv = 1.0f / l; bf16_t* op = AB + (size_t)(b * SEQ + tq) * D + GW + 64 * hd + 4 * h;
#pragma unroll
                        for (int rg = 0; rg < 4; ++rg) { u32x2 w; w.x = cvt_pk_bf16(o0[4 * rg] * inv, o0[4 * rg + 1] * inv); w.y = cvt_pk_bf16(o0[4 * rg + 2] * inv, o0[4 * rg + 3] * inv); *(u32x2*)(op + 8 * rg) = w;
                            w.x = cvt_pk_bf16(o1[4 * rg] * inv, o1[4 * rg + 1] * inv); w.y = cvt_pk_bf16(o1[4 * rg + 2] * inv, o1[4 * rg + 3] * inv); *(u32x2*)(op + 32 + 8 * rg) = w; }
                    }
                }
                __syncthreads();
            }
        }
        STAMP_AT(102);
        for (int item = vcu; item < 256; item += G) {
            const int ch = item >> 1, hh = item & 1; const size_t t0 = (size_t)ch * 128;
            LAS float* rsq = (LAS float*)lds; LAS unsigned char* VN = lds + 512;
            __syncthreads();
            {   u32x4 raw[16];
#pragma unroll
                for (int i = 0; i < 16; ++i) raw[i] = *(const u32x4*)(P1 + (t0 + wave * 16 + i) * P1W + GW + 8 * lane);
                float ssv[16];
#pragma unroll
                for (int i = 0; i < 16; ++i) { float ss = 0.f;
#pragma unroll
                    for (int j = 0; j < 4; ++j) { const float a = bf_lo(raw[i][j]), bq = bf_hi(raw[i][j]); ss += a * a + bq * bq; }
                    ssv[i] = ss; }
#pragma unroll
                for (int o = 1; o < 64; o <<= 1) {
#pragma unroll
                    for (int i = 0; i < 16; ++i) ssv[i] += __shfl_xor(ssv[i], o); }
                float mine = 0.f;
#pragma unroll
                for (int i = 0; i < 16; ++i) mine = (lane == i) ? ssv[i] : mine;
                if (lane < 16) rsq[wave * 16 + lane] = 1.0f / sqrtf(mine * (1.0f / GW) + EPS); }
            u32x4 raw2[8];
#pragma unroll
            for (int i = 0; i < 8; ++i) { const int id = tid + 512 * i, row = id >> 5, cc = id & 31; raw2[i] = *(const u32x4*)(P1 + (t0 + row) * P1W + GW + 256 * hh + 8 * cc); }
            __syncthreads();
#pragma unroll
            for (int i = 0; i < 8; ++i) { const int id = tid + 512 * i, row = id >> 5, cc = id & 31; const u32x4 raw = raw2[i];
                const float rr = rsq[row]; const f32x4 g0 = *(const f32x4*)(args.in[4] + 256 * hh + 8 * cc), g1v = *(const f32x4*)(args.in[4] + 256 * hh + 8 * cc + 4);
                u32x4 w; w.x = cvt_pk_bf16(bf_lo(raw.x) * rr * g0[0], bf_hi(raw.x) * rr * g0[1]); w.y = cvt_pk_bf16(bf_lo(raw.y) * rr * g0[2], bf_hi(raw.y) * rr * g0[3]);
                w.z = cvt_pk_bf16(bf_lo(raw.z) * rr * g1v[0], bf_hi(raw.z) * rr * g1v[1]); w.w = cvt_pk_bf16(bf_lo(raw.w) * rr * g1v[2], bf_hi(raw.w) * rr * g1v[3]);
                *(LAS u32x4*)(VN + row * 576 + 16 * cc) = w; }
            __syncthreads();
            {
                const int gl = wave >> 1, th = wave & 1, grp = 4 * hh + gl, c = lane & 31, h = lane >> 5, gi = lane & 15, g1 = (lane >> 4) & 1;
                f32x16 acc[2][2];
#pragma unroll
                for (int a = 0; a < 2; ++a)
#pragma unroll
                    for (int bq = 0; bq < 2; ++bq)
#pragma unroll
                        for (int i = 0; i < 16; ++i) acc[a][bq][i] = 0.f;
                const bf16_t* wbase = WSP + ((size_t)grp * 128 + 64 * th + c) * 128 + 8 * h;
#pragma unroll
                for (int ks = 0; ks < 8; ++ks) {
                    bf16x8 wf[2], af[2];
#pragma unroll
                    for (int tt = 0; tt < 2; ++tt) wf[tt] = *(const bf16x8*)(wbase + (size_t)(32 * tt) * 128 + 16 * ks);
#pragma unroll
                    for (int dt = 0; dt < 2; ++dt) { const LAS unsigned char* vb = VN + (16 * ks + 8 * h + (gi >> 2)) * 576 + (64 * gl + 32 * dt + 16 * g1 + 4 * (gi & 3)) * 2;
                        const s16x4 vlo = tr_read(vb), vhi = tr_read(vb + 4 * 576);
                        af[dt] = (bf16x8){vlo[0], vlo[1], vlo[2], vlo[3], vhi[0], vhi[1], vhi[2], vhi[3]}; }
#pragma unroll
                    for (int dt = 0; dt < 2; ++dt)
#pragma unroll
                        for (int tt = 0; tt < 2; ++tt) acc[dt][tt] = __builtin_amdgcn_mfma_f32_32x32x16_bf16(af[dt], wf[tt], acc[dt][tt], 0, 0, 0);
                }
#pragma unroll
                for (int tt = 0; tt < 2; ++tt) { const int tl = 64 * th + 32 * tt + c; const size_t row = t0 + tl; const float bias = args.in[6][grp * 128 + tl];
#pragma unroll
                    for (int dt = 0; dt < 2; ++dt)
#pragma unroll
                        for (int rg = 0; rg < 4; ++rg) { const int col = 64 * grp + 32 * dt + 8 * rg + 4 * h; const u32x2 uw = *(const u32x2*)(P1 + row * P1W + col);
                            const float a0 = bf_lo(uw.x) * (acc[dt][tt][4 * rg] + bias), a1 = bf_hi(uw.x) * (acc[dt][tt][4 * rg + 1] + bias), a2 = bf_lo(uw.y) * (acc[dt][tt][4 * rg + 2] + bias), a3 = bf_hi(uw.y) * (acc[dt][tt][4 * rg + 3] + bias);
                            u32x2 w; w.x = cvt_pk_bf16(a0, a1); w.y = cvt_pk_bf16(a2, a3); *(u32x2*)(AB + row * D + col) = w; } }
            }
            __syncthreads();
        }
    }
    STAMP_AT(103);
    SEAM(2);

    STAMP_AT(3);
    if (IN(3)) {
        pg8::Gemm g{AB, PAT, T, D, D, nullptr}; pg8::StaticOrder S; S.init(T, D, G, bx, -1);
        pg8::EpiMerge E{GT, MG};
        pg8::gemm_phase<pg8::EpiMerge>(lds, g, S, E);
    }
    SEAM(3);

    STAMP_AT(4);
    if (IN(4)) {
        pg8::Gemm g{MG, WOT, T, D, D, nullptr}; pg8::StaticOrder S; S.init(T, D, G, bx, -1);
        pg8::EpiResid E{X, X1B};
        pg8::gemm_phase<pg8::EpiResid>(lds, g, S, E);
    }
    SEAM(4);
#ifdef EXTRA_BARS
    for (int xb = 0; xb < EXTRA_BARS; ++xb) GRID_BAR();
#endif

    STAMP_AT(5);
    if (IN(5)) {
        LAS float* wrt = (LAS float*)lds;
        __syncthreads();
        for (int i = tid; i < 4096; i += 512) { const int cc = i >> 2, e4 = (i & 3) * 4; const f32x4 w = *(const f32x4*)(args.in[11] + cc * 16 + e4);
            wrt[(e4 + 0) * 1024 + cc] = w[0]; wrt[(e4 + 1) * 1024 + cc] = w[1]; wrt[(e4 + 2) * 1024 + cc] = w[2]; wrt[(e4 + 3) * 1024 + cc] = w[3]; }
        __syncthreads();
        f32x4 gg[4];
#pragma unroll
        for (int j = 0; j < 4; ++j) gg[j] = *((const f32x4*)args.in[10] + lane + 64 * j);
        u32x2 nxw[4][4];
#pragma unroll
        for (int rr = 0; rr < 4; ++rr) { const int row = (gw + rr * NGW < T) ? gw + rr * NGW : gw;
#pragma unroll
            for (int j = 0; j < 4; ++j) nxw[rr][j] = *((const u32x2*)(X1B + (size_t)row * D) + lane + 64 * j); }
        for (int row0 = gw; row0 < T; row0 += 4 * NGW) {
            f32x4 v[4][4]; float ss[4];
#pragma unroll
            for (int rr = 0; rr < 4; ++rr) {
#pragma unroll
                for (int j = 0; j < 4; ++j) { const u32x2 xw = nxw[rr][j]; v[rr][j] = (f32x4){bf_lo(xw.x), bf_hi(xw.x), bf_lo(xw.y), bf_hi(xw.y)}; } }
            { const int rown0 = (row0 + 4 * NGW < T) ? row0 + 4 * NGW : row0;
#pragma unroll
              for (int rr = 0; rr < 4; ++rr) { const int row = (rown0 + rr * NGW < T) ? rown0 + rr * NGW : rown0;
#pragma unroll
                  for (int j = 0; j < 4; ++j) nxw[rr][j] = *((const u32x2*)(X1B + (size_t)row * D) + lane + 64 * j); } }
#pragma unroll
            for (int rr = 0; rr < 4; ++rr) { float a = 0.f;
#pragma unroll
                for (int j = 0; j < 4; ++j) a += (v[rr][j].x * v[rr][j].x + v[rr][j].y * v[rr][j].y) + (v[rr][j].z * v[rr][j].z + v[rr][j].w * v[rr][j].w);
                ss[rr] = a; }
#pragma unroll
            for (int o = 1; o < 64; o <<= 1) {
#pragma unroll
                for (int rr = 0; rr < 4; ++rr) ss[rr] += __shfl_xor(ss[rr], o); }
#pragma unroll
            for (int rr = 0; rr < 4; ++rr) { const int row = row0 + rr * NGW; const float r = 1.0f / sqrtf(ss[rr] * (1.0f / D) + EPS);
#pragma unroll
                for (int j = 0; j < 4; ++j) { v[rr][j] = v[rr][j] * r * gg[j];
                    if (row < T) { u32x2 w; w.x = cvt_pk_bf16(v[rr][j][0], v[rr][j][1]); w.y = cvt_pk_bf16(v[rr][j][2], v[rr][j][3]); *((u32x2*)(H2 + (size_t)row * D) + lane + 64 * j) = w; } } }
            float val[64];
#pragma unroll
            for (int e = 0; e < 16; ++e) { float a0 = 0.f, a1 = 0.f, a2 = 0.f, a3 = 0.f;
#pragma unroll
                for (int j = 0; j < 4; ++j) { const f32x4 w = *(const LAS f32x4*)(wrt + e * 1024 + 4 * lane + 256 * j);
                    a0 += (v[0][j][0] * w[0] + v[0][j][1] * w[1]) + (v[0][j][2] * w[2] + v[0][j][3] * w[3]); a1 += (v[1][j][0] * w[0] + v[1][j][1] * w[1]) + (v[1][j][2] * w[2] + v[1][j][3] * w[3]);
                    a2 += (v[2][j][0] * w[0] + v[2][j][1] * w[1]) + (v[2][j][2] * w[2] + v[2][j][3] * w[3]); a3 += (v[3][j][0] * w[0] + v[3][j][1] * w[1]) + (v[3][j][2] * w[2] + v[3][j][3] * w[3]); }
                val[e] = a0; val[16 + e] = a1; val[32 + e] = a2; val[48 + e] = a3; }
#pragma unroll
            for (int off = 32, n = 64; off >= 1; off >>= 1, n >>= 1) { const bool up = (lane & off) != 0;
#pragma unroll
                for (int k = 0; k < n / 2; ++k) { const float a = val[k], bq = val[k + n / 2]; const float send = up ? a : bq, keep = up ? bq : a; val[k] = keep + __shfl_xor(send, off); } }
            const float lg = val[0];
            float mx = lg;
#pragma unroll
            for (int o = 8; o >= 1; o >>= 1) mx = fmaxf(mx, __shfl_xor(mx, o));
            const float pe = __expf(lg - mx); float den = pe;
#pragma unroll
            for (int o = 8; o >= 1; o >>= 1) den += __shfl_xor(den, o);
            const int row = row0 + (lane >> 4) * NGW;
            if (row < T) AFF[((size_t)(row >> 12) * NE + (lane & 15)) * SEQ + (row & (SEQ - 1))] = pe / den;
        }
    }
    SEAM(5);

    STAMP_AT(6);
    if (IN(6)) {
        for (int item = vcu; item < 256; item += G) {
            const int be = item >> 2, qtr = item & 3, b = be >> 4, e = be & 15;
            LAS int* wsum = (LAS int*)lds;
            LAS int* idxl = (LAS int*)(lds + 256);
            __syncthreads();
            unsigned v[8];
            { const float* ap = AFF + (size_t)be * SEQ + 8 * tid; const f32x4 a0 = *(const f32x4*)ap, a1 = *(const f32x4*)(ap + 4);
#pragma unroll
              for (int i = 0; i < 4; ++i) { v[i] = __float_as_uint(a0[i]); v[4 + i] = __float_as_uint(a1[i]); } }
            unsigned prefix = 0u;
            for (int bit = 30; bit >= 0; --bit) {
                const unsigned cand = prefix | (1u << bit); int cnt = 0;
#pragma unroll
                for (int i = 0; i < 8; ++i) cnt += (v[i] >= cand) ? 1 : 0;
                cnt = wave_sum_i(cnt);
                if (lane == 0) wsum[(bit & 1) * 8 + wave] = cnt;
                __syncthreads();
                int tot = 0;
#pragma unroll
                for (int w = 0; w < 8; ++w) tot += wsum[(bit & 1) * 8 + w];
                if (tot >= CAP) prefix = cand;
            }
            const unsigned tau = prefix;
            int cgt = 0, ceq = 0;
#pragma unroll
            for (int i = 0; i < 8; ++i) { cgt += (v[i] > tau) ? 1 : 0; ceq += (v[i] == tau) ? 1 : 0; }
            int sce = ceq;
#pragma unroll
            for (int o = 1; o < 64; o <<= 1) { const int y = __shfl_up(sce, o); if (lane >= o) sce += y; }
            const int wgt = wave_sum_i(cgt);
            if (lane == 63) wsum[16 + wave] = sce;
            if (lane == 0) wsum[24 + wave] = wgt;
            __syncthreads();
            int ngt = 0, eqbase = sce - ceq;
#pragma unroll
            for (int w = 0; w < 8; ++w) { ngt += wsum[24 + w]; eqbase += (w < wave) ? wsum[16 + w] : 0; }
            const int need = CAP - ngt;
            unsigned selm = 0u; int nsel = 0, er = eqbase;
#pragma unroll
            for (int i = 0; i < 8; ++i) { bool sel = v[i] > tau; if (v[i] == tau) { sel = er < need; ++er; } if (sel) { selm |= (1u << i); ++nsel; } }
            int scs = nsel;
#pragma unroll
            for (int o = 1; o < 64; o <<= 1) { const int y = __shfl_up(scs, o); if (lane >= o) scs += y; }
            if (lane == 63) wsum[32 + wave] = scs;
            __syncthreads();
            int slot = scs - nsel;
#pragma unroll
            for (int w = 0; w < 8; ++w) slot += (w < wave) ? wsum[32 + w] : 0;
            const bool wr_slot = (tid >> 7) == qtr;
#pragma unroll
            for (int i = 0; i < 8; ++i) { const int tok = 8 * tid + i; const bool sel = (selm >> i) & 1u;
                if (sel && (slot >> 7) == qtr) { GATE[(size_t)(e * NB + b) * CAP + slot] = __uint_as_float(v[i]); ROWTOK[(size_t)(e * NB + b) * CAP + slot] = b * SEQ + tok; }
                if (wr_slot) SLOT[((size_t)b * SEQ + tok) * NE + e] = sel ? (short)slot : (short)-1;
                if (sel) ++slot; }
            (void)idxl;
        }
    }
    SEAM(6);

    STAMP_AT(7);
    if (IN(7)) {
        pg8::Gemm g{H2, WGU, MROWS, 2 * EH, D, ROWTOK}; pg8::StaticOrder S; S.init(MROWS, 2 * EH, G, bx, 3);
        pg8::EpiSwiGLU E{ACT};
        pg8::gemm_phase<pg8::EpiSwiGLU, true, true, true>(lds, g, S, E);
    }
    SEAM(7);

    STAMP_AT(8);
    if (IN(8)) {
        pg8::Gemm g{ACT, WDT, MROWS, D, EH, nullptr}; pg8::StaticOrder S; S.init(MROWS, D, G, bx, 3);
        pg8::EpiDown E{YB, GATE};
        pg8::gemm_phase<pg8::EpiDown>(lds, g, S, E);
    }
    SEAM(8);

    STAMP_AT(9);
    if (IN(9)) {
        f32x4 gg[4];
#pragma unroll
        for (int j = 0; j < 4; ++j) gg[j] = *((const f32x4*)args.in[15] + lane + 64 * j);
        u32x2 nx9[4]; u32x4 ns0, ns1;
#pragma unroll
        for (int j = 0; j < 4; ++j) nx9[j] = *((const u32x2*)(X1B + (size_t)gw * D) + lane + 64 * j);
        ns0 = *(const u32x4*)(SLOT + (size_t)gw * NE); ns1 = *(const u32x4*)(SLOT + (size_t)gw * NE + 8);
        for (int row = gw; row < T; row += NGW) {
            const int b = row >> 12; const int rn = (row + NGW < T) ? row + NGW : row;
            f32x4 v[4];
#pragma unroll
            for (int j = 0; j < 4; ++j) v[j] = (f32x4){bf_lo(nx9[j].x), bf_hi(nx9[j].x), bf_lo(nx9[j].y), bf_hi(nx9[j].y)};
            const u32x4 s0 = ns0, s1 = ns1;
#pragma unroll
            for (int j = 0; j < 4; ++j) nx9[j] = *((const u32x2*)(X1B + (size_t)rn * D) + lane + 64 * j);
            ns0 = *(const u32x4*)(SLOT + (size_t)rn * NE); ns1 = *(const u32x4*)(SLOT + (size_t)rn * NE + 8);
#pragma unroll
            for (int e = 0; e < 16; ++e) { const unsigned w = (e < 8) ? s0[(e & 7) >> 1] : s1[(e & 7) >> 1]; int sl = (int)(short)((e & 1) ? (w >> 16) : (w & 0xffffu)); sl = __builtin_amdgcn_readfirstlane(sl);
                if (sl >= 0) { const bf16_t* yp = YB + ((size_t)(e * NB + b) * CAP + sl) * D + 4 * lane;
#pragma unroll
                    for (int j = 0; j < 4; ++j) { const u32x2 yw = __builtin_nontemporal_load((const u32x2*)(yp + 256 * j)); v[j][0] += bf_lo(yw.x); v[j][1] += bf_hi(yw.x); v[j][2] += bf_lo(yw.y); v[j][3] += bf_hi(yw.y); } } }
            float s = 0.f;
#pragma unroll
            for (int j = 0; j < 4; ++j) s += (v[j].x * v[j].x + v[j].y * v[j].y) + (v[j].z * v[j].z + v[j].w * v[j].w);
            const float r = 1.0f / sqrtf(wave_sum(s) * (1.0f / D) + EPS);
#pragma unroll
            for (int j = 0; j < 4; ++j) __builtin_nontemporal_store(v[j] * r * gg[j], (f32x4*)(OUT + (size_t)row * D) + lane + 64 * j);
        }
    }
    STAMP_AT(10);
#ifdef STAMP_LO
    if (bx == STAMP_BLK && tid == 0) { const unsigned long long t0 = __builtin_amdgcn_s_memrealtime(), want = (ts1 - ts0) * STAMP_AMP; while (__builtin_amdgcn_s_memrealtime() - t0 < want) __builtin_amdgcn_s_sleep(8); }
#endif
#undef IN
#undef SEAM
}

extern "C" void kernel_launch(void* const* d_in, const int* in_sizes, int n_in, void* d_out, int out_size, void* d_ws, size_t ws_size, hipStream_t stream) {
    static int grid = 0;
    if (grid == 0) {
        if (n_in != 16 || in_sizes[0] != T * D || out_size != T * D || ws_size < WS_END) { fprintf(stderr, "kernel_launch: unexpected shapes (n_in %d, in0 %d, out %d, ws %zu < %zu)\n", n_in, n_in > 0 ? in_sizes[0] : -1, out_size, ws_size, (size_t)WS_END); grid = -1; return; }
        int dev = 0, cus = 0, per_cu = 0;
        if (hipGetDevice(&dev) != hipSuccess || hipDeviceGetAttribute(&cus, hipDeviceAttributeMultiprocessorCount, dev) != hipSuccess) { grid = -1; return; }
        if (hipFuncSetAttribute((const void*)mk_fwd, hipFuncAttributeMaxDynamicSharedMemorySize, LDS_BYTES) != hipSuccess) { fprintf(stderr, "kernel_launch: hipFuncSetAttribute failed\n"); grid = -1; return; }
        if (hipOccupancyMaxActiveBlocksPerMultiprocessor(&per_cu, (const void*)mk_fwd, NWAVES * 64, LDS_BYTES) != hipSuccess || per_cu < 1) { fprintf(stderr, "kernel_launch: occupancy query says %d blocks/CU\n", per_cu); per_cu = 1; }
        (void)hipGetLastError();
        grid = cus;
    }
    if (grid < 0) return;
    (void)hipMemsetAsync((char*)d_ws + WS_CTL, 0, 1 * MiB, stream);
    Args a{};
    for (int i = 0; i < 16; ++i) a.in[i] = (const float*)d_in[i];
    a.out = (float*)d_out; a.ws = (unsigned char*)d_ws;
#if MK_MODE == 0
    for (int p = 0; p < NPH; ++p) { a.ph_lo = p; a.ph_hi = p + 1; hipLaunchKernelGGL(mk_fwd, dim3(grid), dim3(NWAVES * 64), LDS_BYTES, stream, a); }
#elif MK_MODE == 1
    a.ph_lo = 0; a.ph_hi = NPH;
    void* kargs[] = {&a};
    hipError_t e = hipLaunchCooperativeKernel((const void*)mk_fwd, dim3(grid), dim3(NWAVES * 64), kargs, LDS_BYTES, stream);
    if (e != hipSuccess) fprintf(stderr, "kernel_launch: cooperative launch failed: %s\n", hipGetErrorString(e));
#else
    a.ph_lo = 0; a.ph_hi = NPH;
    hipLaunchKernelGGL(mk_fwd, dim3(grid), dim3(NWAVES * 64), LDS_BYTES, stream, a);
#endif
}
```

```cpp
#include <hip/hip_runtime.h>
#include <hip/hip_cooperative_groups.h>
#include <cstdio>
#include <cstdint>

#ifndef MK_MODE
#define MK_MODE 2
#endif

#ifndef STAMP_AMP
#define STAMP_AMP 4
#endif
#ifndef STAMP_BLK
#define STAMP_BLK 0
#endif
#define LAS __attribute__((address_space(3)))
typedef unsigned short bf16_t;
typedef short bf16x8 __attribute__((ext_vector_type(8)));
typedef short s16x4 __attribute__((ext_vector_type(4)));
typedef float f32x2 __attribute__((ext_vector_type(2)));
typedef float f32x4 __attribute__((ext_vector_type(4)));
typedef float f32x16 __attribute__((ext_vector_type(16)));
typedef unsigned u32x2 __attribute__((ext_vector_type(2)));
typedef unsigned u32x4 __attribute__((ext_vector_type(4)));

constexpr int NB = 4, SEQ = 4096, T = NB * SEQ, D = 1024;
constexpr int GW = 512, AW = 512, NH = 8, HD = 64;
constexpr int INC = 2 * GW + 3 * AW + 2 * D;
constexpr int P1W = 2 * GW;
constexpr int GTW = 2 * D;
constexpr int NE = 16, EH = 1024, CAP = 512;
constexpr int MROWS = NE * NB * CAP;
constexpr float EPS = 1e-6f;
constexpr float LOG2E = 1.4426950408889634f;
constexpr int NPH = 10;

constexpr size_t MiB = 1u << 20;
constexpr size_t WS_CTL = 0;
constexpr size_t WS_WSP = 1 * MiB;
constexpr size_t WS_GATE = 1 * MiB + 512 * 1024;
constexpr size_t WS_ROWTOK = 1 * MiB + 768 * 1024;
constexpr size_t WS_SLOT = 2 * MiB;
constexpr size_t WS_AFF = 3 * MiB;
constexpr size_t WS_PAT = 5 * MiB;
constexpr size_t WS_WOT = 7 * MiB;
constexpr size_t WS_WGU = 9 * MiB;
constexpr size_t WS_WDT = 73 * MiB;
constexpr size_t WS_P1 = 105 * MiB;
constexpr size_t WS_QH = 137 * MiB, WS_KH = 153 * MiB, WS_VH = 169 * MiB;
constexpr size_t WS_MG = 105 * MiB;
constexpr size_t WS_ACT = 105 * MiB;
constexpr size_t WS_Y = 169 * MiB;
constexpr size_t WS_GT = 185 * MiB;
constexpr size_t WS_H2 = 201 * MiB;
constexpr size_t WS_H = 249 * MiB;
constexpr size_t WS_A = 249 * MiB;
constexpr size_t WS_X1 = 249 * MiB;
constexpr size_t WS_END = 281 * MiB;
constexpr int SCR_STRIDE = 68;

__device__ __forceinline__ unsigned cvt_pk_bf16(float lo, float hi) { unsigned r; asm volatile("v_cvt_pk_bf16_f32 %0, %1, %2" : "=v"(r) : "v"(lo), "v"(hi)); return r; }
typedef __bf16 bf16x2_t __attribute__((ext_vector_type(2)));
__device__ __forceinline__ unsigned cvt_pk_fast(float lo, float hi) { const f32x2 v = {lo, hi}; const bf16x2_t b = __builtin_convertvector(v, bf16x2_t); return __builtin_bit_cast(unsigned, b); }
__device__ __forceinline__ float bf_lo(unsigned w) { return __uint_as_float(w << 16); }
__device__ __forceinline__ float bf_hi(unsigned w) { return __uint_as_float(w & 0xffff0000u); }
__device__ __forceinline__ float wave_sum(float v) {
#pragma unroll
    for (int o = 1; o < 64; o <<= 1) v += __shfl_xor(v, o);
    return v;
}
__device__ __forceinline__ int wave_sum_i(int v) {
#pragma unroll
    for (int o = 1; o < 64; o <<= 1) v += __shfl_xor(v, o);
    return v;
}
__device__ __forceinline__ float fast_sigmoid(float y) { return __builtin_amdgcn_rcpf(1.0f + __builtin_amdgcn_exp2f(-LOG2E * y)); }
__device__ __forceinline__ float gelu_tanh(float x) {
    const float z = 0.7978845608028654f * (x + 0.044715f * x * x * x);
    return x * __builtin_amdgcn_rcpf(1.0f + __builtin_amdgcn_exp2f(-2.0f * LOG2E * z));
}

namespace pg8 {
constexpr int BM = 256, BK = 64, HALF = 128, HTB = HALF * BK * 2, STAGE_BYTES = 8 * HTB, NXCD = 8, WGM = 8;
__host__ __device__ __forceinline__ int lds_byte(int r, int c) { const int st = (r >> 4) * 2 + (c >> 5), rr = r & 15, cc = c & 31, ob = rr * 64 + cc * 2; return st * 1024 + (ob ^ (((ob >> 9) & 1) << 5)); }
__host__ __device__ __forceinline__ void stage_rc(int b, int& R, int& C) { const int st = b / 1024, sb = b % 1024, swz = sb ^ (((sb >> 9) & 1) << 5); R = (st >> 1) * 16 + swz / 64; C = (st & 1) * 32 + (swz % 64) / 2; }
__host__ __device__ __forceinline__ int perm32(int rho) { const int n = rho >> 4, i = rho & 15; return 8 * (i >> 2) + 4 * n + (i & 3); }

struct Unit { int pm, pn; };
struct Gemm { const bf16_t* A; const bf16_t* Bt; int M, N, K; const int* rowtok; };

struct StaticOrder {
    int nM, nN, nwg, G, c, gsh, N, ibeg, iend;
    __device__ void init(int M, int N_, int G_, int c_, int gsh_, int ibeg_ = 0, int iend_ = 1 << 20) { nM = M / BM; nN = N_ / BM; nwg = nM * nN; G = G_; c = c_; gsh = gsh_; N = N_; ibeg = ibeg_; iend = iend_; }
    __device__ bool next(int i, Unit& u) const {
        if (i + ibeg >= iend) return false;
        const long L = (long)(i + ibeg) * G + c; if (L >= nwg) return false;
        int wgid = (int)L; { const int q = nwg / NXCD, r = nwg % NXCD, xcd = wgid % NXCD, off = wgid / NXCD; wgid = (xcd < r ? xcd * (q + 1) : r * (q + 1) + (xcd - r) * q) + off; }
        const int nig = WGM * nN, gid = wgid / nig, fm = gid * WGM, gsz = (nM - fm) < WGM ? (nM - fm) : WGM;
        u.pm = fm + ((wgid % nig) % gsz); u.pn = (wgid % nig) / gsz; return true;
    }
    __device__ __forceinline__ int brow(const Unit& u) const { return (gsh >= 0 ? (u.pm >> gsh) * N : 0) + u.pn * BM; }
};

template <class Epi, bool ALIGN_EPI = true, bool SP2 = true, bool GATHER = false>
__device__ __forceinline__ void gemm_phase(LAS unsigned char* lds, const Gemm g, const StaticOrder& S, const Epi& E) {
    static_assert(!GATHER || SP2, "the gathered A operand is implemented for the SP2 loop");
    const int tid = threadIdx.x, wid = __builtin_amdgcn_readfirstlane(tid >> 6), lane = tid & 63, wr = wid >> 2, wc = wid & 3, fr = lane & 15, fq = lane >> 4;
    const int K = g.K, nt = K / BK;
    unsigned voffA[2], voffB[2];
#pragma unroll
    for (int i = 0; i < 2; ++i) { int R, C; stage_rc(tid * 16 + i * 8192, R, C); const int Rb = Epi::PERM ? ((R & ~31) + perm32(R & 31)) : R;
        voffA[i] = (unsigned)(R * K + C) * 2u; voffB[i] = (unsigned)(Rb * K + C) * 2u; }
    const size_t kstep = (size_t)(BK * 2);
    const size_t hstep = (size_t)HALF * K * 2;
    const size_t tstep = 2 * hstep;
    const size_t rstep = (size_t)K * 2;
    const unsigned ldsw = (unsigned)wid * 1024u;
    const int aoff = lds_byte(wr * 64 + fr, fq * 8), boff = lds_byte(wc * 32 + fr, fq * 8);
#define PG8_SA(b, h) (((b) * 2 + (h)) * HTB)
#define PG8_SB(b, h) ((4 + (b) * 2 + (h)) * HTB)
#define PG8_STAGE(bufoff, gbase, voff) do { _Pragma("unroll") for (int _i = 0; _i < 2; ++_i) \
        __builtin_amdgcn_global_load_lds((const unsigned*)((const char*)(gbase) + (voff)[_i]), (LAS unsigned*)(lds + (bufoff) + ldsw + _i * 8192), 16, 0, 0); } while (0)
#define PG8_LDA(dst, b, h) do { _Pragma("unroll") for (int m = 0; m < 4; ++m) _Pragma("unroll") for (int k = 0; k < 2; ++k) dst[m][k] = *(const LAS bf16x8*)(lds + PG8_SA(b, h) + aoff + m * 2048 + k * 1024); } while (0)
#define PG8_LDB(dst, b, h) do { _Pragma("unroll") for (int n = 0; n < 2; ++n) _Pragma("unroll") for (int k = 0; k < 2; ++k) dst[n][k] = *(const LAS bf16x8*)(lds + PG8_SB(b, h) + boff + n * 2048 + k * 1024); } while (0)
#define PG8_MMA(ai, bj, At, Bt) do { __builtin_amdgcn_s_setprio(1); _Pragma("unroll") for (int m = 0; m < 4; ++m) _Pragma("unroll") for (int n = 0; n < 2; ++n) _Pragma("unroll") for (int k = 0; k < 2; ++k) \
        acc[ai][bj][m][n] = __builtin_amdgcn_mfma_f32_16x16x32_bf16(Bt[n][k], At[m][k], acc[ai][bj][m][n], 0, 0, 0); __builtin_amdgcn_s_setprio(0); } while (0)
#define PG8_WAIT_V(n) asm volatile("s_waitcnt vmcnt(" #n ")" ::: "memory")
#define PG8_WAIT_L(n) asm volatile("s_waitcnt lgkmcnt(" #n ")" ::: "memory")
#define PG8_BAR __builtin_amdgcn_s_barrier()
#define PG8_SCHED __builtin_amdgcn_sched_barrier(0)
    unsigned gAc[2][2], gAn[2][2];
#define PG8_GOFF(dst, u) do { if constexpr (GATHER) { _Pragma("unroll") for (int _h = 0; _h < 2; ++_h) _Pragma("unroll") for (int _i = 0; _i < 2; ++_i) { int R_, C_; stage_rc(tid * 16 + _i * 8192, R_, C_); \
        dst[_h][_i] = (unsigned)g.rowtok[(u).pm * BM + _h * HALF + R_] * (unsigned)(K * 2) + (unsigned)(C_ * 2); } } } while (0)
#define PG8_STAGEA(bufoff, SEL, H, KT) do { if constexpr (GATHER) { const char* _b = (const char*)g.A + (size_t)(KT) * kstep; \
        _Pragma("unroll") for (int _i = 0; _i < 2; ++_i) __builtin_amdgcn_global_load_lds((const unsigned*)(_b + ((SEL) ? gAn[H][_i] : gAc[H][_i])), (LAS unsigned*)(lds + (bufoff) + ldsw + _i * 8192), 16, 0, 0); } \
        else { const char* _b = ((SEL) ? nA : cA) + (size_t)(H) * hstep + (size_t)(KT) * kstep; PG8_STAGE(bufoff, _b, voffA); } } while (0)
    Unit cur, nxt; int ui = 0;
    if (!S.next(0, cur)) return;
    PG8_GOFF(gAc, cur);
    f32x4 acc[2][2][4][2];
#pragma unroll
    for (int a = 0; a < 2; ++a)
#pragma unroll
        for (int b = 0; b < 2; ++b)
#pragma unroll
            for (int m = 0; m < 4; ++m)
#pragma unroll
                for (int n = 0; n < 2; ++n) acc[a][b][m][n] = (f32x4){0.f, 0.f, 0.f, 0.f};
    bf16x8 At[4][2], B0[2][2], B1[2][2];
    const char* cA = (const char*)g.A + (size_t)cur.pm * tstep; const char* cB = (const char*)g.Bt + (size_t)S.brow(cur) * rstep;
    const char* nA = cA;
    if constexpr (SP2) {
        PG8_STAGE(PG8_SB(0, 0), cB, voffB); PG8_STAGE(PG8_SB(0, 1), cB + hstep, voffB); PG8_STAGEA(PG8_SA(0, 0), 0, 0, 0); PG8_STAGEA(PG8_SA(0, 1), 0, 1, 0);
        if (wr == 1) PG8_BAR;
        PG8_WAIT_V(2); PG8_BAR;
        PG8_STAGE(PG8_SB(1, 0), cB + kstep, voffB); PG8_STAGEA(PG8_SA(1, 0), 0, 0, 1); PG8_STAGE(PG8_SB(1, 1), cB + hstep + kstep, voffB);
        PG8_WAIT_V(6); PG8_BAR;
    } else {
        PG8_STAGE(PG8_SB(0, 0), cB, voffB); PG8_STAGE(PG8_SA(0, 0), cA, voffA); PG8_STAGE(PG8_SB(0, 1), cB + hstep, voffB); PG8_STAGE(PG8_SA(0, 1), cA + hstep, voffA);
        if (wr == 1) PG8_BAR;
        PG8_WAIT_V(4); PG8_BAR;
        PG8_STAGE(PG8_SB(1, 0), cB + kstep, voffB); PG8_STAGE(PG8_SA(1, 0), cA + kstep, voffA); PG8_STAGE(PG8_SB(1, 1), cB + hstep + kstep, voffB);
        PG8_WAIT_V(6); PG8_BAR;
    }
    for (;;) {
        const bool has_next = S.next(ui + 1, nxt);
        nA = has_next ? (const char*)g.A + (size_t)nxt.pm * tstep : cA; const char* nB = has_next ? (const char*)g.Bt + (size_t)S.brow(nxt) * rstep : cB;
        if constexpr (GATHER) { if (has_next) PG8_GOFF(gAn, nxt); else {
#pragma unroll
            for (int _h = 0; _h < 2; ++_h)
#pragma unroll
                for (int _i = 0; _i < 2; ++_i) gAn[_h][_i] = gAc[_h][_i]; } }
        for (int t = 0; t < nt; t += 2) {
            const bool last = (t == nt - 2);
            if constexpr (Epi::MIDK) { if (t == E.midt(nt)) E.mid(acc, cur, wr, wc, fr, fq); }
            const char* a1 = cA + (size_t)(t + 1) * kstep;
            const char* a2 = last ? nA : cA + (size_t)(t + 2) * kstep; const char* b2 = last ? nB : cB + (size_t)(t + 2) * kstep;
            const char* a3 = a2 + kstep; const char* b3 = b2 + kstep;
            if constexpr (SP2) {
            const int sel2 = last ? 1 : 0, kt2 = last ? 0 : t + 2;
            PG8_LDB(B0, 0, 0); PG8_LDB(B1, 0, 1); PG8_SCHED; PG8_LDA(At, 0, 0); PG8_STAGEA(PG8_SA(1, 1), 0, 1, t + 1);
            PG8_WAIT_V(8); PG8_WAIT_L(0); PG8_BAR; PG8_MMA(0, 0, At, B0); PG8_MMA(0, 1, At, B1); PG8_BAR; PG8_SCHED;
            PG8_LDA(At, 0, 1); PG8_STAGE(PG8_SB(0, 0), b2, voffB); PG8_STAGE(PG8_SB(0, 1), b2 + hstep, voffB); PG8_STAGEA(PG8_SA(0, 0), sel2, 0, kt2);
            PG8_WAIT_V(8); PG8_WAIT_L(0); PG8_BAR; PG8_MMA(1, 0, At, B0); PG8_MMA(1, 1, At, B1); PG8_BAR; PG8_SCHED;
            PG8_LDB(B0, 1, 0); PG8_LDB(B1, 1, 1); PG8_SCHED; PG8_LDA(At, 1, 0); PG8_STAGEA(PG8_SA(0, 1), sel2, 1, kt2);
            PG8_WAIT_V(8); PG8_WAIT_L(0); PG8_BAR; PG8_MMA(0, 0, At, B0); PG8_MMA(0, 1, At, B1); PG8_BAR; PG8_SCHED;
            PG8_LDA(At, 1, 1); PG8_STAGE(PG8_SB(1, 0), b3, voffB); PG8_STAGE(PG8_SB(1, 1), b3 + hstep, voffB); PG8_STAGEA(PG8_SA(1, 0), sel2, 0, kt2 + 1);
            PG8_WAIT_V(8); PG8_WAIT_L(0); PG8_BAR; PG8_MMA(1, 0, At, B0); PG8_MMA(1, 1, At, B1); PG8_BAR; PG8_SCHED;
            } else {
            PG8_LDB(B0, 0, 0); PG8_SCHED; PG8_LDA(At, 0, 0); PG8_STAGE(PG8_SA(1, 1), a1 + hstep, voffA);
            PG8_WAIT_L(8); PG8_BAR; PG8_WAIT_L(0); PG8_MMA(0, 0, At, B0); PG8_BAR; PG8_SCHED;
            PG8_LDB(B1, 0, 1); PG8_STAGE(PG8_SB(0, 0), b2, voffB);
            PG8_BAR; PG8_WAIT_L(0); PG8_MMA(0, 1, At, B1); PG8_BAR;
            PG8_LDA(At, 0, 1); PG8_STAGE(PG8_SA(0, 0), a2, voffA);
            PG8_BAR; PG8_WAIT_L(0); PG8_MMA(1, 0, At, B0); PG8_BAR; PG8_SCHED;
            PG8_STAGE(PG8_SB(0, 1), b2 + hstep, voffB);
            PG8_WAIT_V(6); PG8_BAR; PG8_MMA(1, 1, At, B1); PG8_BAR;
            PG8_LDB(B0, 1, 0); PG8_SCHED; PG8_LDA(At, 1, 0); PG8_STAGE(PG8_SA(0, 1), a2 + hstep, voffA);
            PG8_WAIT_L(8); PG8_BAR; PG8_WAIT_L(0); PG8_MMA(0, 0, At, B0); PG8_BAR; PG8_SCHED;
            PG8_LDB(B1, 1, 1); PG8_STAGE(PG8_SB(1, 0), b3, voffB);
            PG8_BAR; PG8_WAIT_L(0); PG8_MMA(0, 1, At, B1); PG8_BAR;
            PG8_LDA(At, 1, 1); PG8_STAGE(PG8_SA(1, 0), a3, voffA);
            PG8_BAR; PG8_WAIT_L(0); PG8_MMA(1, 0, At, B0); PG8_BAR; PG8_SCHED;
            PG8_STAGE(PG8_SB(1, 1), b3 + hstep, voffB);
            PG8_WAIT_V(6); PG8_BAR; PG8_MMA(1, 1, At, B1); PG8_BAR;
            }
        }
        if constexpr (ALIGN_EPI) { if (wr == 0) PG8_BAR; }
        E(acc, cur, wr, wc, fr, fq);
        if (!has_next) break;
#pragma unroll
        for (int a = 0; a < 2; ++a)
#pragma unroll
            for (int b = 0; b < 2; ++b)
#pragma unroll
                for (int m = 0; m < 4; ++m)
#pragma unroll
                    for (int n = 0; n < 2; ++n) acc[a][b][m][n] = (f32x4){0.f, 0.f, 0.f, 0.f};
        cur = nxt; cA = nA; cB = nB; ++ui;
        if constexpr (GATHER) {
#pragma unroll
            for (int _h = 0; _h < 2; ++_h)
#pragma unroll
                for (int _i = 0; _i < 2; ++_i) gAc[_h][_i] = gAn[_h][_i]; }
        if constexpr (ALIGN_EPI) { if (wr == 1) PG8_BAR; }
    }
    PG8_WAIT_V(0);
    if constexpr (!ALIGN_EPI) { if (wr == 0) PG8_BAR; }
    PG8_BAR;
#undef PG8_SA
#undef PG8_SB
#undef PG8_STAGE
#undef PG8_STAGEA
#undef PG8_GOFF
#undef PG8_LDA
#undef PG8_LDB
#undef PG8_MMA
#undef PG8_WAIT_V
#undef PG8_WAIT_L
#undef PG8_BAR
#undef PG8_SCHED
}

typedef const f32x4 (&AccRef)[2][2][4][2];
typedef f32x4 (&AccMut)[2][2][4][2];

struct EpiProj {
    static constexpr bool PERM = true, MIDK = false;
    bf16_t* UV; bf16_t* QKV; bf16_t* GT; const float* bgate;
    __device__ __forceinline__ void operator()(AccRef acc, const Unit& u, int wr, int wc, int fr, int fq) const {
        const int pn = u.pn, row0 = u.pm * BM + wr * 64 + fr, cl = wc * 32 + 8 * fq;
        const bool isg = pn >= 10, ishm = pn >= 4 && pn < 10;
        const int mode = isg ? 3 : (pn < 4 ? 1 : (pn < 6 ? 2 : 0));
        f32x4 bv[2][2];
#pragma unroll
        for (int bj = 0; bj < 2; ++bj)
#pragma unroll
            for (int n = 0; n < 2; ++n) bv[bj][n] = isg ? *(const f32x4*)(bgate + (pn - 10) * 256 + bj * HALF + cl + 4 * n) : (f32x4){0.f, 0.f, 0.f, 0.f};
#pragma unroll
        for (int ai = 0; ai < 2; ++ai)
#pragma unroll
            for (int m = 0; m < 4; ++m) { const int row = row0 + ai * HALF + m * 16;
#pragma unroll
                for (int bj = 0; bj < 2; ++bj) { f32x4 v0 = acc[ai][bj][m][0], v1 = acc[ai][bj][m][1];
                    if (mode == 1) {
#pragma unroll
                        for (int j = 0; j < 4; ++j) { v0[j] = gelu_tanh(v0[j]); v1[j] = gelu_tanh(v1[j]); } }
                    else if (mode == 2) { v0 = v0 * (0.125f * LOG2E); v1 = v1 * (0.125f * LOG2E); }
                    else if (mode == 3) { v0 = v0 + bv[bj][0]; v1 = v1 + bv[bj][1];
#pragma unroll
                        for (int j = 0; j < 4; ++j) { v0[j] = fast_sigmoid(v0[j]); v1[j] = fast_sigmoid(v1[j]); } }
                    u32x4 w; w.x = cvt_pk_bf16(v0[0], v0[1]); w.y = cvt_pk_bf16(v0[2], v0[3]); w.z = cvt_pk_bf16(v1[0], v1[1]); w.w = cvt_pk_bf16(v1[2], v1[3]);
                    bf16_t* dst;
                    if (isg) dst = GT + (size_t)row * GTW + (pn - 10) * 256 + bj * HALF + cl;
                    else if (ishm) { const int col = ((pn - 4) & 1) * 256 + bj * HALF + cl;
                        dst = QKV + (size_t)((pn - 4) >> 1) * ((size_t)T * AW) + ((size_t)((row >> 12) * NH + (col >> 6)) * SEQ + (row & (SEQ - 1))) * HD + (col & 63); }
                    else dst = UV + (size_t)row * P1W + pn * 256 + bj * HALF + cl;
                    *(u32x4*)dst = w; } }
    }
};
struct EpiMerge {
    static constexpr bool PERM = true, MIDK = true;
    const bf16_t* GT; bf16_t* MG;
    __device__ __forceinline__ int midt(int nt) const { return nt / 2; }
    __device__ __forceinline__ void mid(AccMut acc, const Unit& u, int wr, int wc, int fr, int fq) const {
        asm volatile("" : "+v"(fr), "+v"(fq));
        const int row0 = u.pm * BM + wr * 64 + fr, col0 = u.pn * BM + wc * 32 + 8 * fq;
#pragma unroll
        for (int ai = 0; ai < 2; ++ai)
#pragma unroll
            for (int m = 0; m < 4; ++m) { const bf16_t* gp = GT + (size_t)(row0 + ai * HALF + m * 16) * GTW + col0;
#pragma unroll
                for (int bj = 0; bj < 2; ++bj) { const u32x4 ga = *(const u32x4*)(gp + bj * HALF), gb = *(const u32x4*)(gp + D + bj * HALF);
#pragma unroll
                    for (int j = 0; j < 2; ++j) { acc[ai][bj][m][0][2 * j] *= bf_lo(ga[j]) * __builtin_amdgcn_rcpf(fmaxf(bf_lo(gb[j]), 1e-18f)); acc[ai][bj][m][0][2 * j + 1] *= bf_hi(ga[j]) * __builtin_amdgcn_rcpf(fmaxf(bf_hi(gb[j]), 1e-18f));
                        acc[ai][bj][m][1][2 * j] *= bf_lo(ga[2 + j]) * __builtin_amdgcn_rcpf(fmaxf(bf_lo(gb[2 + j]), 1e-18f)); acc[ai][bj][m][1][2 * j + 1] *= bf_hi(ga[2 + j]) * __builtin_amdgcn_rcpf(fmaxf(bf_hi(gb[2 + j]), 1e-18f)); } }
                if (m == 3) asm volatile("" ::: "memory"); }
    }
    __device__ __forceinline__ void operator()(AccRef acc, const Unit& u, int wr, int wc, int fr, int fq) const {
        const int row0 = u.pm * BM + wr * 64 + fr, col0 = u.pn * BM + wc * 32 + 8 * fq;
#pragma unroll
        for (int ai = 0; ai < 2; ++ai)
#pragma unroll
            for (int m = 0; m < 4; ++m) { const size_t r = (size_t)(row0 + ai * HALF + m * 16);
#pragma unroll
                for (int bj = 0; bj < 2; ++bj) { const u32x4 gb = *(const u32x4*)(GT + r * GTW + D + col0 + bj * HALF); const f32x4 v0 = acc[ai][bj][m][0], v1 = acc[ai][bj][m][1];
                    u32x4 w; w.x = cvt_pk_bf16(v0[0] * fmaxf(bf_lo(gb[0]), 1e-18f), v0[1] * fmaxf(bf_hi(gb[0]), 1e-18f)); w.y = cvt_pk_bf16(v0[2] * fmaxf(bf_lo(gb[1]), 1e-18f), v0[3] * fmaxf(bf_hi(gb[1]), 1e-18f));
                    w.z = cvt_pk_bf16(v1[0] * fmaxf(bf_lo(gb[2]), 1e-18f), v1[1] * fmaxf(bf_hi(gb[2]), 1e-18f)); w.w = cvt_pk_bf16(v1[2] * fmaxf(bf_lo(gb[3]), 1e-18f), v1[3] * fmaxf(bf_hi(gb[3]), 1e-18f));
                    *(u32x4*)(MG + r * D + col0 + bj * HALF) = w; } }
    }
};
struct EpiResid {
    static constexpr bool PERM = false, MIDK = false;
    const float* X; bf16_t* X1;
    __device__ __forceinline__ void operator()(AccRef acc, const Unit& u, int wr, int wc, int fr, int fq) const {
        const int row0 = u.pm * BM + wr * 64 + fr, col0 = u.pn * BM + wc * 32 + 4 * fq;
#pragma unroll
        for (int ai = 0; ai < 2; ++ai)
#pragma unroll
            for (int m = 0; m < 4; ++m) { const size_t r = (size_t)(row0 + ai * HALF + m * 16);
#pragma unroll
                for (int bj = 0; bj < 2; ++bj)
#pragma unroll
                    for (int n = 0; n < 2; ++n) { const int c = col0 + bj * HALF + n * 16;
                        const f32x4 o = *(const f32x4*)(X + r * D + c) + acc[ai][bj][m][n];
                        u32x2 w; w.x = cvt_pk_bf16(o[0], o[1]); w.y = cvt_pk_bf16(o[2], o[3]); *(u32x2*)(X1 + r * D + c) = w; } }
    }
};
struct EpiSwiGLU {
    static constexpr bool PERM = true, MIDK = false;
    bf16_t* ACT;
    __device__ __forceinline__ void operator()(AccRef acc, const Unit& u, int wr, int wc, int fr, int fq) const {
        const int row0 = u.pm * BM + wr * 64 + fr, col0 = u.pn * HALF + wc * 32 + 8 * fq;
#pragma unroll
        for (int ai = 0; ai < 2; ++ai)
#pragma unroll
            for (int m = 0; m < 4; ++m) { bf16_t* rowp = ACT + (size_t)(row0 + ai * HALF + m * 16) * EH + col0;
                f32x4 o[2];
#pragma unroll
                for (int n = 0; n < 2; ++n) { const f32x4 gg = acc[ai][0][m][n], uu = acc[ai][1][m][n];
#pragma unroll
                    for (int j = 0; j < 4; ++j) o[n][j] = gg[j] * fast_sigmoid(gg[j]) * uu[j]; }
                u32x4 w; w.x = cvt_pk_bf16(o[0][0], o[0][1]); w.y = cvt_pk_bf16(o[0][2], o[0][3]); w.z = cvt_pk_bf16(o[1][0], o[1][1]); w.w = cvt_pk_bf16(o[1][2], o[1][3]);
                *(u32x4*)rowp = w; }
    }
};
struct EpiDown {
    static constexpr bool PERM = true, MIDK = false;
    bf16_t* Y; const float* gate;
    __device__ __forceinline__ void operator()(AccRef acc, const Unit& u, int wr, int wc, int fr, int fq) const {
        const int row0 = u.pm * BM + wr * 64 + fr, col0 = u.pn * BM + wc * 32 + 8 * fq;
#pragma unroll
        for (int ai = 0; ai < 2; ++ai)
#pragma unroll
            for (int m = 0; m < 4; ++m) { const int r = row0 + ai * HALF + m * 16; const float gt = gate[r]; bf16_t* rowp = Y + (size_t)r * D + col0;
#pragma unroll
                for (int bj = 0; bj < 2; ++bj) { const f32x4 v0 = acc[ai][bj][m][0] * gt, v1 = acc[ai][bj][m][1] * gt;
                    u32x4 w; w.x = cvt_pk_bf16(v0[0], v0[1]); w.y = cvt_pk_bf16(v0[2], v0[3]); w.z = cvt_pk_bf16(v1[0], v1[1]); w.w = cvt_pk_bf16(v1[2], v1[3]);
                    *(u32x4*)(rowp + bj * HALF) = w; } }
    }
};
}

#define XB_TMO      128
#define XB_XCNT(j)  (256  + 64 * (j))
#define XB_XSUB(j)  (1280 + 64 * (j))
#define XB_XGEN(j)  (2304 + 64 * (j))
#define XB_TOP      3328
#define XB_TOPGEN   3392
#define XCD_BAR_WORDS 3456
#define XB_SPIN_CAP (1u << 18)
__device__ __forceinline__ unsigned xb_ld(unsigned* p)              { return __hip_atomic_load(p, __ATOMIC_RELAXED, __HIP_MEMORY_SCOPE_AGENT); }
__device__ __forceinline__ unsigned xb_add(unsigned* p, unsigned v) { return __hip_atomic_fetch_add(p, v, __ATOMIC_RELAXED, __HIP_MEMORY_SCOPE_AGENT); }
__device__ __forceinline__ unsigned xb_xcc_id() { return (unsigned)__builtin_amdgcn_s_getreg((3 << 11) | 20) & 0xFu; }
#define XB_SPIN(cond, bar) do { unsigned _sp = 0; while (cond) { __builtin_amdgcn_s_sleep(1); \
    if ((++_sp & 255u) == 0u) { if (xb_ld(&(bar)[XB_TMO])) break; if (_sp > XB_SPIN_CAP) { atomicAdd(&(bar)[XB_TMO], 1u); break; } } } } while (0)
struct XcdBarrier { unsigned* bar; unsigned x; volatile LAS unsigned* st; };
__device__ __forceinline__ XcdBarrier xcd_barrier_post(unsigned* bar, volatile LAS unsigned* st) {
    XcdBarrier b; b.bar = bar; b.x = xb_xcc_id(); b.st = st;
    if (threadIdx.x == 0) (void)xb_add(&bar[XB_XCNT(b.x)], 1u);
    return b;
}
__device__ __forceinline__ void xcd_barrier_complete(unsigned* bar, unsigned x, unsigned& nloc, unsigned& nx) {
    const unsigned G = gridDim.x * gridDim.y * gridDim.z;
    unsigned sum, cnt, mine, sp = 0u;
    for (;;) {
        sum = 0u; cnt = 0u; mine = 0u;
#pragma unroll
        for (unsigned j = 0; j < 16; ++j) { const unsigned c = xb_ld(&bar[XB_XCNT(j)]); sum += c; cnt += (c > 0u) ? 1u : 0u; mine = (j == x) ? c : mine; }
        if (sum == G) break;
        __builtin_amdgcn_s_sleep(1);
        if ((++sp & 255u) == 0u) { if (xb_ld(&bar[XB_TMO])) break; if (sp > XB_SPIN_CAP) { atomicAdd(&bar[XB_TMO], 1u); break; } }
    }
    nloc = mine > 0u ? mine : 1u; nx = cnt > 0u ? cnt : 1u;
}
__device__ __forceinline__ void xcd_barrier(const XcdBarrier& b) {
    asm volatile("s_waitcnt vmcnt(0)" ::: "memory");
    __syncthreads();
    if (threadIdx.x == 0) {
        unsigned* bar = b.bar;
        __builtin_amdgcn_s_waitcnt(0);
        unsigned nloc = b.st[0], nx = b.st[1];
        if (nloc == 0u) { xcd_barrier_complete(bar, b.x, nloc, nx); b.st[0] = nloc; b.st[1] = nx; }
        const unsigned old = xb_add(&bar[XB_XSUB(b.x)], 1u);
        const unsigned gen = old / nloc;
        if (old + 1u == (gen + 1u) * nloc) {
            __builtin_amdgcn_fence(__ATOMIC_RELEASE, "agent");
            asm volatile("s_waitcnt vmcnt(0)" ::: "memory");
            const unsigned og = xb_add(&bar[XB_TOP], 1u);
            const unsigned tg = og / nx;
            if (og + 1u == (tg + 1u) * nx) xb_add(&bar[XB_TOPGEN], 1u);
            else XB_SPIN(xb_ld(&bar[XB_TOPGEN]) == tg, bar);
            __builtin_amdgcn_fence(__ATOMIC_ACQUIRE, "agent");
            xb_add(&bar[XB_XGEN(b.x)], 1u);
            asm volatile("s_waitcnt vmcnt(0)" ::: "memory");
        } else {
            XB_SPIN(xb_ld(&bar[XB_XGEN(b.x)]) == gen, bar);
            __builtin_amdgcn_fence(__ATOMIC_ACQUIRE, "agent");
            asm volatile("s_waitcnt vmcnt(0)" ::: "memory");
        }
    }
    __syncthreads();
}

constexpr int NWAVES = 8;
constexpr int LDS_BYTES = 147456;
constexpr int MISC_OFF = 144 * 1024 - 256;
constexpr int CW_BAR = 4096;

struct Args { const float* in[16]; float* out; unsigned char* ws; int ph_lo, ph_hi; };

struct TileRegs { f32x4 v[16]; };
__device__ __forceinline__ void tile_load(TileRegs& t, const float* W, int N, int k0, int n0, int lane) {
    const int n4 = (lane & 15) * 4, kq = lane >> 4;
#pragma unroll
    for (int i = 0; i < 16; ++i) t.v[i] = __builtin_nontemporal_load((const f32x4*)(W + (size_t)(k0 + 4 * i + kq) * N + n0 + n4));
}
__device__ __forceinline__ void tile_store(const TileRegs& t, int k0, bf16_t* WT, int Kd, int drow0, LAS float* scr, int lane) {
    const int n4 = (lane & 15) * 4, kq = lane >> 4;
#pragma unroll
    for (int i = 0; i < 16; ++i) { LAS float* s = scr + (4 * i + kq) * 65 + n4; s[0] = t.v[i][0]; s[1] = t.v[i][1]; s[2] = t.v[i][2]; s[3] = t.v[i][3]; }
    asm volatile("s_waitcnt lgkmcnt(0)" ::: "memory");
    const int c = lane & 7;
#pragma unroll
    for (int jj = 0; jj < 8; ++jj) { const int n = (lane >> 3) + 8 * jj; const LAS float* s = scr + (8 * c) * 65 + n;
        u32x4 o; o.x = cvt_pk_fast(s[0], s[65]); o.y = cvt_pk_fast(s[2 * 65], s[3 * 65]); o.z = cvt_pk_fast(s[4 * 65], s[5 * 65]); o.w = cvt_pk_fast(s[6 * 65], s[7 * 65]);
        __builtin_nontemporal_store(o, (u32x4*)(WT + (size_t)(drow0 + n) * Kd + k0 + 8 * c)); }
    asm volatile("s_waitcnt lgkmcnt(0)" ::: "memory");
}
__device__ __forceinline__ void transpose_tile(const float* W, int N, int k0, int n0, bf16_t* WT, int Kd, int drow0, LAS float* scr, int lane) {
    TileRegs t; tile_load(t, W, N, k0, n0, lane); tile_store(t, k0, WT, Kd, drow0, scr, lane);
}
struct ExTile { const float* W; int N, k0, n0; bf16_t* WT; int Kd, drow0; };
__device__ __forceinline__ ExTile expert_tile(int it, const float* wg, const float* wu, const float* wd, bf16_t* WGU, bf16_t* WDT) {
    const int e = it / 768, q = it % 768, kind = q / 256, t = q % 256, k0 = 64 * (t / 16), n0 = 64 * (t % 16);
    ExTile x; x.k0 = k0; x.n0 = n0;
    if (kind < 2) { x.W = (kind == 0 ? wg : wu) + (size_t)e * D * EH; x.N = EH; x.WT = WGU + (size_t)e * 2048 * D; x.Kd = D; x.drow0 = 256 * (n0 >> 7) + 128 * kind + (n0 & 127); }
    else { x.W = wd + (size_t)e * EH * D; x.N = D; x.WT = WDT + (size_t)e * D * EH; x.Kd = EH; x.drow0 = n0; }
    return x;
}
__device__ __forceinline__ void rms_regs_to_bf16(const f32x4 (&v)[4], const f32x4 (&gg)[4], bf16_t* orow, int lane) {
    float s = 0.f;
#pragma unroll
    for (int j = 0; j < 4; ++j) s += (v[j].x * v[j].x + v[j].y * v[j].y) + (v[j].z * v[j].z + v[j].w * v[j].w);
    const float r = 1.0f / sqrtf(wave_sum(s) * (1.0f / D) + EPS);
#pragma unroll
    for (int j = 0; j < 4; ++j) { const f32x4 o = v[j] * r * gg[j]; u32x2 w; w.x = cvt_pk_bf16(o[0], o[1]); w.y = cvt_pk_bf16(o[2], o[3]); *((u32x2*)orow + lane + 64 * j) = w; }
}

__device__ __forceinline__ s16x4 tr_read(const LAS unsigned char* p) {
    typedef short v4i16_t __attribute__((ext_vector_type(4)));
    return __builtin_bit_cast(s16x4, __builtin_amdgcn_ds_read_tr16_b64_v4i16((LAS v4i16_t*)p));
}

__device__ __forceinline__ float xmax(float v) { auto rr = __builtin_amdgcn_permlane32_swap(__float_as_uint(v), __float_as_uint(v), false, false); return fmaxf(__uint_as_float(rr[0]), __uint_as_float(rr[1])); }
__device__ __forceinline__ float xsum(float v) { auto rr = __builtin_amdgcn_permlane32_swap(__float_as_uint(v), __float_as_uint(v), false, false); return __uint_as_float(rr[0]) + __uint_as_float(rr[1]); }

__global__ void __launch_bounds__(NWAVES * 64, 2) mk_fwd(Args args) {
    extern __shared__ __attribute__((aligned(16))) unsigned char lds_raw[];
    LAS unsigned char* lds = (LAS unsigned char*)lds_raw;
    const int tid = threadIdx.x, lane = tid & 63, wave = __builtin_amdgcn_readfirstlane(tid >> 6);
    const int G = gridDim.x, bx = blockIdx.x;
    const int vcu = (G % 8 == 0) ? (bx % 8) * (G / 8) + bx / 8 : bx;
    const int gw = vcu * NWAVES + wave, NGW = G * NWAVES;
    unsigned char* ws = args.ws;
    float* OUT = args.out;
    const float* X = args.in[0];
    bf16_t* WSP = (bf16_t*)(ws + WS_WSP); float* GATE = (float*)(ws + WS_GATE); int* ROWTOK = (int*)(ws + WS_ROWTOK); short* SLOT = (short*)(ws + WS_SLOT); float* AFF = (float*)(ws + WS_AFF);
    bf16_t* PAT = (bf16_t*)(ws + WS_PAT); bf16_t* WOT = (bf16_t*)(ws + WS_WOT);
    bf16_t* WGU = (bf16_t*)(ws + WS_WGU); bf16_t* WDT = (bf16_t*)(ws + WS_WDT);
    bf16_t* QH = (bf16_t*)(ws + WS_QH); bf16_t* P1 = (bf16_t*)(ws + WS_P1); bf16_t* MG = (bf16_t*)(ws + WS_MG); bf16_t* YB = (bf16_t*)(ws + WS_Y); bf16_t* H2 = (bf16_t*)(ws + WS_H2); bf16_t* X1B = (bf16_t*)(ws + WS_X1);
    bf16_t* ACT = (bf16_t*)(ws + WS_ACT); bf16_t* GT = (bf16_t*)(ws + WS_GT);
    bf16_t* HB = (bf16_t*)(ws + WS_H); bf16_t* AB = (bf16_t*)(ws + WS_A);
    bf16_t* WIT = (bf16_t*)OUT;
    float* SCR = OUT;

#if MK_MODE == 2
    volatile LAS unsigned* MISC = (volatile LAS unsigned*)(lds + MISC_OFF);
    if (tid < 64) MISC[tid] = 0u;
    __syncthreads();
    XcdBarrier bar = xcd_barrier_post((unsigned*)(ws + WS_CTL) + CW_BAR, MISC + 8);
#define GRID_BAR() xcd_barrier(bar)
#elif MK_MODE == 1
#define GRID_BAR() cooperative_groups::this_grid().sync()
#else
#define GRID_BAR() do {} while (0)
#endif
#ifdef STAMP_LO
    unsigned long long ts0 = 0, ts1 = 0;
#define STAMP_AT(k) do { if ((k) == STAMP_LO) ts0 = __builtin_amdgcn_s_memrealtime(); if ((k) == STAMP_HI) ts1 = __builtin_amdgcn_s_memrealtime(); } while (0)
#else
#define STAMP_AT(k) do {} while (0)
#endif
    const int lo = args.ph_lo, hi = args.ph_hi;
#define IN(k) (lo <= (k) && (k) < hi)
#define SEAM(k) do { if (IN(k) && IN((k) + 1)) GRID_BAR(); } while (0)

    STAMP_AT(0);
    if (IN(0)) {
        LAS float* scr = (LAS float*)(lds + wave * 16640);
        constexpr int I_IN = 16 * 72, I_PA = 8 * 16, I_WO = 16 * 16, I_EX = 16 * 16;
        constexpr int NITEMS = I_IN + 2 * I_PA + I_WO;
        (void)I_EX;
        for (int it = gw; it < NITEMS; it += NGW) {
            int r = it;
            if (r < I_IN) { transpose_tile(args.in[2], INC, 64 * (r / 72), 64 * (r % 72), WIT, D, 64 * (r % 72), scr, lane); continue; } r -= I_IN;
            if (r < I_PA) { transpose_tile(args.in[7], D, 64 * (r / 16), 64 * (r % 16), PAT, D, 64 * (r % 16), scr, lane); continue; } r -= I_PA;
            if (r < I_PA) { transpose_tile(args.in[8], D, 64 * (r / 16), 64 * (r % 16), PAT + GW, D, 64 * (r % 16), scr, lane); continue; } r -= I_PA;
            transpose_tile(args.in[9], D, 64 * (r / 16), 64 * (r % 16), WOT, D, 64 * (r % 16), scr, lane);
        }
        { const float* wsrc = args.in[5];
          for (int i = (vcu * 512 + tid) * 4; i < 8 * 128 * 128; i += G * 512 * 4) { const f32x4 v = *(const f32x4*)(wsrc + i); u32x2 w; w.x = cvt_pk_bf16(v[0], v[1]); w.y = cvt_pk_bf16(v[2], v[3]); *(u32x2*)(WSP + i) = w; } }
        f32x4 gg[4];
#pragma unroll
        for (int j = 0; j < 4; ++j) gg[j] = *((const f32x4*)args.in[1] + lane + 64 * j);
        { f32x4 cur[4];
#pragma unroll
          for (int j = 0; j < 4; ++j) cur[j] = __builtin_nontemporal_load((const f32x4*)(X + (size_t)gw * D) + lane + 64 * j);
          for (int m = gw; m < T; m += NGW) { f32x4 nx[4]; const int mn = (m + NGW < T) ? m + NGW : m;
#pragma unroll
            for (int j = 0; j < 4; ++j) nx[j] = __builtin_nontemporal_load((const f32x4*)(X + (size_t)mn * D) + lane + 64 * j);
            rms_regs_to_bf16(cur, gg, HB + (size_t)m * D, lane);
#pragma unroll
            for (int j = 0; j < 4; ++j) cur[j] = nx[j]; } }
    }
    SEAM(0);

    STAMP_AT(1);
    if (IN(1)) {
        const bool full5 = (G == 256) ? (bx < 128) : true;
        const int ncv = (G == 256) ? (full5 ? 32 : 64) : (12288 + G - 1) / G, cv0 = (G == 256) ? (full5 ? bx * 32 : 128 * 32 + (bx - 128) * 64) : bx * ncv;
        const int cvsplit = (bx >> 3) & 3;
#define CONVERT_EXPERTS() do { LAS float* scr = (LAS float*)(lds + wave * 16640); const int itend = (cv0 + ncv < 12288) ? cv0 + ncv : 12288; \
            int it = cv0 + wave; TileRegs tr; ExTile xt; \
            if (it < itend) { xt = expert_tile(it, args.in[12], args.in[13], args.in[14], WGU, WDT); tile_load(tr, xt.W, xt.N, xt.k0, xt.n0, lane); } \
            while (it < itend) { const ExTile xc = xt; const TileRegs tc = tr; it += NWAVES; \
                if (it < itend) { xt = expert_tile(it, args.in[12], args.in[13], args.in[14], WGU, WDT); tile_load(tr, xt.W, xt.N, xt.k0, xt.n0, lane); } \
                tile_store(tc, xc.k0, xc.WT, xc.Kd, xc.drow0, scr, lane); } \
            __syncthreads(); } while (0)
        pg8::Gemm g{HB, WIT, T, INC, D, nullptr}; pg8::EpiProj E{P1, QH, GT, args.in[3]};
        if (cvsplit > 0) { pg8::StaticOrder S; S.init(T, INC, G, bx, -1, 0, cvsplit); pg8::gemm_phase<pg8::EpiProj>(lds, g, S, E); }
        STAMP_AT(110);
        CONVERT_EXPERTS();
        STAMP_AT(111);
        if (cvsplit < 5) { pg8::StaticOrder S; S.init(T, INC, G, bx, -1, cvsplit, 1 << 20); pg8::gemm_phase<pg8::EpiProj>(lds, g, S, E); }
#undef CONVERT_EXPERTS
    }
    STAMP_AT(114);
    SEAM(1);

    STAMP_AT(2);
    if (IN(2)) {
        for (int item = vcu; item < NB * NH * 8; item += G) {
            const int bh = item >> 3, blk = item & 7, b = bh >> 3, hd = bh & 7, Q0 = blk * 512;
            const float slope2 = __builtin_amdgcn_exp2f(-(float)(hd + 1)) * LOG2E;
            const bf16_t* qp = QH + (size_t)bh * SEQ * HD; const bf16_t* kp = qp + (size_t)T * AW; const bf16_t* vp = kp + (size_t)T * AW;
            LAS unsigned char* Kt = lds + wave * 10752; LAS unsigned char* Vt = Kt + 4608;
            const int c = lane & 31, h = lane >> 5, gi = lane & 15, g1 = (lane >> 4) & 1;
            float* scrI = SCR + (size_t)item * (512 * SCR_STRIDE);
            for (int pi = 0; pi < 3; ++pi) {
                const int dls = 4 - 2 * pi, nseq = SEQ >> dls;
                const float pen = slope2 * (float)(1 << dls);
                for (int uu = 0; uu < 2; ++uu) {
                    const int u = wave + 8 * uu, ql = 4 - dls, r = u >> ql, qt = u & ((1 << ql) - 1);
                    const int nq0 = (Q0 >> dls) + 32 * qt, tq = r + ((nq0 + c) << dls), qi = tq - Q0, nb = nq0 - 64;
                    bf16x8 qf[4];
                    { const bf16_t* qrow = qp + (size_t)tq * HD + 8 * h;
#pragma unroll
                      for (int ks = 0; ks < 4; ++ks) qf[ks] = *(const bf16x8*)(qrow + 16 * ks); }
                    f32x16 o0, o1; float m, l;
                    float* sp = scrI + (size_t)qi * SCR_STRIDE;
                    if (pi == 0) {
#pragma unroll
                        for (int i = 0; i < 16; ++i) { o0[i] = 0.f; o1[i] = 0.f; }
                        m = -1e30f; l = 0.f;
                    } else {
#pragma unroll
                        for (int rg = 0; rg < 4; ++rg) { const f32x4 a = *(const f32x4*)(sp + 8 * rg + 4 * h), bq = *(const f32x4*)(sp + 32 + 8 * rg + 4 * h);
#pragma unroll
                            for (int j = 0; j < 4; ++j) { o0[4 * rg + j] = a[j]; o1[4 * rg + j] = bq[j]; } }
                        m = sp[64]; l = sp[65];
                    }
                    float pb[16];
#pragma unroll
                    for (int i = 0; i < 16; ++i) pb[i] = pen * (float)((i & 3) + 8 * (i >> 2) + 4 * h - c);
                    const bool edge = (nb < 0) || (nb + 160 > nseq);
                    u32x4 kr[4], vr[4];
#define ATT_LOAD(kt) do { _Pragma("unroll") for (int it = 0; it < 4; ++it) { int nk = nb + 32 * (kt) + (lane >> 3) + 8 * it; nk = nk < 0 ? 0 : (nk > nseq - 1 ? nseq - 1 : nk); \
                        const size_t off = (size_t)(r + (nk << dls)) * HD + 8 * (lane & 7); kr[it] = *(const u32x4*)(kp + off); vr[it] = *(const u32x4*)(vp + off); } } while (0)
                    ATT_LOAD(0);
#pragma unroll
                    for (int kt = 0; kt < 5; ++kt) {
#pragma unroll
                        for (int it = 0; it < 4; ++it) { const int row = (lane >> 3) + 8 * it; *(LAS u32x4*)(Kt + row * 144 + 16 * (lane & 7)) = kr[it]; *(LAS u32x4*)(Vt + row * 192 + 16 * (lane & 7)) = vr[it]; }
                        if (kt < 4) ATT_LOAD(kt + 1);
                        f32x16 s;
#pragma unroll
                        for (int i = 0; i < 16; ++i) s[i] = 0.f;
#pragma unroll
                        for (int ks = 0; ks < 4; ++ks) { const bf16x8 kf = *(const LAS bf16x8*)(Kt + c * 144 + 32 * ks + 16 * h); s = __builtin_amdgcn_mfma_f32_32x32x16_bf16(kf, qf[ks], s, 0, 0, 0); }
                        const float cst = pen * (float)(32 * kt - 64);
#pragma unroll
                        for (int i = 0; i < 16; ++i) {
                            if (kt < 2) s[i] = s[i] + (pb[i] + cst); else if (kt == 2) s[i] = s[i] - __builtin_fabsf(pb[i]); else s[i] = s[i] - (pb[i] + cst);
                            if (kt == 0) s[i] = (pb[i] >= 0.f) ? s[i] : -INFINITY;
                            if (kt == 4) s[i] = (pb[i] <= 0.f) ? s[i] : -INFINITY; }
                        if (edge) {
#pragma unroll
                            for (int i = 0; i < 16; ++i) { const int nk = nb + 32 * kt + (i & 3) + 8 * (i >> 2) + 4 * h; s[i] = (nk >= 0 && nk < nseq) ? s[i] : -INFINITY; } }
                        float mx = fmaxf(fmaxf(s[0], s[1]), fmaxf(s[2], s[3]));
#pragma unroll
                        for (int i = 4; i < 16; i += 4) mx = fmaxf(mx, fmaxf(fmaxf(s[i], s[i + 1]), fmaxf(s[i + 2], s[i + 3])));
                        mx = xmax(mx);
                        const float mn = (mx > m + 8.0f) ? mx : m, alpha = __builtin_amdgcn_exp2f(m - mn);
                        float rs = 0.f;
#pragma unroll
                        for (int i = 0; i < 16; ++i) { s[i] = __builtin_amdgcn_exp2f(s[i] - mn); rs += s[i]; }
                        rs = xsum(rs);
                        l = l * alpha + rs;
                        if (__any(mn > m)) {
#pragma unroll
                            for (int i = 0; i < 16; ++i) { o0[i] *= alpha; o1[i] *= alpha; } }
                        m = mn;
                        bf16x8 pf[2];
#pragma unroll
                        for (int s2 = 0; s2 < 2; ++s2) { const unsigned w0 = cvt_pk_bf16(s[8 * s2 + 0], s[8 * s2 + 1]), w1 = cvt_pk_bf16(s[8 * s2 + 2], s[8 * s2 + 3]), w2 = cvt_pk_bf16(s[8 * s2 + 4], s[8 * s2 + 5]), w3 = cvt_pk_bf16(s[8 * s2 + 6], s[8 * s2 + 7]);
                            pf[s2] = __builtin_bit_cast(bf16x8, (u32x4){w0, w1, w2, w3}); }
#pragma unroll
                        for (int s2 = 0; s2 < 2; ++s2)
#pragma unroll
                            for (int dt = 0; dt < 2; ++dt) { const LAS unsigned char* vb = Vt + (16 * s2 + 4 * h + (gi >> 2)) * 192 + (32 * dt + 16 * g1 + 4 * (gi & 3)) * 2;
                                const s16x4 vlo = tr_read(vb), vhi = tr_read(vb + 8 * 192);
                                const bf16x8 vf = (bf16x8){vlo[0], vlo[1], vlo[2], vlo[3], vhi[0], vhi[1], vhi[2], vhi[3]};
                                if (dt == 0) o0 = __builtin_amdgcn_mfma_f32_32x32x16_bf16(vf, pf[s2], o0, 0, 0, 0); else o1 = __builtin_amdgcn_mfma_f32_32x32x16_bf16(vf, pf[s2], o1, 0, 0, 0); }
                    }
#undef ATT_LOAD
                    if (pi < 2) {
#pragma unroll
                        for (int rg = 0; rg < 4; ++rg) { *(f32x4*)(sp + 8 * rg + 4 * h) = (f32x4){o0[4 * rg], o0[4 * rg + 1], o0[4 * rg + 2], o0[4 * rg + 3]};
                            *(f32x4*)(sp + 32 + 8 * rg + 4 * h) = (f32x4){o1[4 * rg], o1[4 * rg + 1], o1[4 * rg + 2], o1[4 * rg + 3]}; }
                        if (h == 0) { sp[64] = m; sp[65] = l; }
                    } else {
                        const float inv = 1.0f / l; bf16_t* op = AB + (size_t)(b * SEQ + tq) * D + GW + 64 * hd + 4 * h;
#pragma unroll
                        for (int rg = 0; rg < 4; ++rg) { u32x2 w; w.x = cvt_pk_bf16(o0[4 * rg] * inv, o0[4 * rg + 1] * inv); w.y = cvt_pk_bf16(o0[4 * rg + 2] * inv, o0[4 * rg + 3] * inv); *(u32x2*)(op + 8 * rg) = w;
                            w.x = cvt_pk_bf16(o1[4 * rg] * inv, o1[4 * rg + 1] * inv); w.y = cvt_pk_bf16(o1[4 * rg + 2] * inv, o1[4 * rg + 3] * inv); *(u32x2*)(op + 32 + 8 * rg) = w; }
                    }
                }
                __syncthreads();
            }
        }
        STAMP_AT(102);
        for (int item = vcu; item < 256; item += G) {
            const int ch = item >> 1, hh = item & 1; const size_t t0 = (size_t)ch * 128;
            LAS float* rsq = (LAS float*)lds; LAS unsigned char* VN = lds + 512;
            __syncthreads();
            {   u32x4 raw[16];
#pragma unroll
                for (int i = 0; i < 16; ++i) raw[i] = *(const u32x4*)(P1 + (t0 + wave * 16 + i) * P1W + GW + 8 * lane);
                float ssv[16];
#pragma unroll
                for (int i = 0; i < 16; ++i) { float ss = 0.f;
#pragma unroll
                    for (int j = 0; j < 4; ++j) { const float a = bf_lo(raw[i][j]), bq = bf_hi(raw[i][j]); ss += a * a + bq * bq; }
                    ssv[i] = ss; }
#pragma unroll
                for (int o = 1; o < 64; o <<= 1) {
#pragma unroll
                    for (int i = 0; i < 16; ++i) ssv[i] += __shfl_xor(ssv[i], o); }
                float mine = 0.f;
#pragma unroll
                for (int i = 0; i < 16; ++i) mine = (lane == i) ? ssv[i] : mine;
                if (lane < 16) rsq[wave * 16 + lane] = 1.0f / sqrtf(mine * (1.0f / GW) + EPS); }
            u32x4 raw2[8];
#pragma unroll
            for (int i = 0; i < 8; ++i) { const int id = tid + 512 * i, row = id >> 5, cc = id & 31; raw2[i] = *(const u32x4*)(P1 + (t0 + row) * P1W + GW + 256 * hh + 8 * cc); }
            __syncthreads();
#pragma unroll
            for (int i = 0; i < 8; ++i) { const int id = tid + 512 * i, row = id >> 5, cc = id & 31; const u32x4 raw = raw2[i];
                const float rr = rsq[row]; const f32x4 g0 = *(const f32x4*)(args.in[4] + 256 * hh + 8 * cc), g1v = *(const f32x4*)(args.in[4] + 256 * hh + 8 * cc + 4);
                u32x4 w; w.x = cvt_pk_bf16(bf_lo(raw.x) * rr * g0[0], bf_hi(raw.x) * rr * g0[1]); w.y = cvt_pk_bf16(bf_lo(raw.y) * rr * g0[2], bf_hi(raw.y) * rr * g0[3]);
                w.z = cvt_pk_bf16(bf_lo(raw.z) * rr * g1v[0], bf_hi(raw.z) * rr * g1v[1]); w.w = cvt_pk_bf16(bf_lo(raw.w) * rr * g1v[2], bf_hi(raw.w) * rr * g1v[3]);
                *(LAS u32x4*)(VN + row * 576 + 16 * cc) = w; }
            __syncthreads();
            {
                const int gl = wave >> 1, th = wave & 1, grp = 4 * hh + gl, c = lane & 31, h = lane >> 5, gi = lane & 15, g1 = (lane >> 4) & 1;
                f32x16 acc[2][2];
#pragma unroll
                for (int a = 0; a < 2; ++a)
#pragma unroll
                    for (int bq = 0; bq < 2; ++bq)
#pragma unroll
                        for (int i = 0; i < 16; ++i) acc[a][bq][i] = 0.f;
                const bf16_t* wbase = WSP + ((size_t)grp * 128 + 64 * th + c) * 128 + 8 * h;
#pragma unroll
                for (int ks = 0; ks < 8; ++ks) {
                    bf16x8 wf[2], af[2];
#pragma unroll
                    for (int tt = 0; tt < 2; ++tt) wf[tt] = *(const bf16x8*)(wbase + (size_t)(32 * tt) * 128 + 16 * ks);
#pragma unroll
                    for (int dt = 0; dt < 2; ++dt) { const LAS unsigned char* vb = VN + (16 * ks + 8 * h + (gi >> 2)) * 576 + (64 * gl + 32 * dt + 16 * g1 + 4 * (gi & 3)) * 2;
                        const s16x4 vlo = tr_read(vb), vhi = tr_read(vb + 4 * 576);
                        af[dt] = (bf16x8){vlo[0], vlo[1], vlo[2], vlo[3], vhi[0], vhi[1], vhi[2], vhi[3]}; }
#pragma unroll
                    for (int dt = 0; dt < 2; ++dt)
#pragma unroll
                        for (int tt = 0; tt < 2; ++tt) acc[dt][tt] = __builtin_amdgcn_mfma_f32_32x32x16_bf16(af[dt], wf[tt], acc[dt][tt], 0, 0, 0);
                }
#pragma unroll
                for (int tt = 0; tt < 2; ++tt) { const int tl = 64 * th + 32 * tt + c; const size_t row = t0 + tl; const float bias = args.in[6][grp * 128 + tl];
#pragma unroll
                    for (int dt = 0; dt < 2; ++dt)
#pragma unroll
                        for (int rg = 0; rg < 4; ++rg) { const int col = 64 * grp + 32 * dt + 8 * rg + 4 * h; const u32x2 uw = *(const u32x2*)(P1 + row * P1W + col);
                            const float a0 = bf_lo(uw.x) * (acc[dt][tt][4 * rg] + bias), a1 = bf_hi(uw.x) * (acc[dt][tt][4 * rg + 1] + bias), a2 = bf_lo(uw.y) * (acc[dt][tt][4 * rg + 2] + bias), a3 = bf_hi(uw.y) * (acc[dt][tt][4 * rg + 3] + bias);
                            u32x2 w; w.x = cvt_pk_bf16(a0, a1); w.y = cvt_pk_bf16(a2, a3); *(u32x2*)(AB + row * D + col) = w; } }
            }
            __syncthreads();
        }
    }
    STAMP_AT(103);
    SEAM(2);

    STAMP_AT(3);
    if (IN(3)) {
        pg8::Gemm g{AB, PAT, T, D, D, nullptr}; pg8::StaticOrder S; S.init(T, D, G, bx, -1);
        pg8::EpiMerge E{GT, MG};
        pg8::gemm_phase<pg8::EpiMerge>(lds, g, S, E);
    }
    SEAM(3);

    STAMP_AT(4);
    if (IN(4)) {
        pg8::Gemm g{MG, WOT, T, D, D, nullptr}; pg8::StaticOrder S; S.init(T, D, G, bx, -1);
        pg8::EpiResid E{X, X1B};
        pg8::gemm_phase<pg8::EpiResid>(lds, g, S, E);
    }
    STAMP_AT(104);
    SEAM(4);
#ifdef EXTRA_BARS
    for (int xb = 0; xb < EXTRA_BARS; ++xb) GRID_BAR();
#endif

    STAMP_AT(5);
    if (IN(5)) {
        LAS float* wrt = (LAS float*)lds;
        __syncthreads();
        for (int i = tid; i < 4096; i += 512) { const int cc = i >> 2, e4 = (i & 3) * 4; const f32x4 w = *(const f32x4*)(args.in[11] + cc * 16 + e4);
            wrt[(e4 + 0) * 1024 + cc] = w[0]; wrt[(e4 + 1) * 1024 + cc] = w[1]; wrt[(e4 + 2) * 1024 + cc] = w[2]; wrt[(e4 + 3) * 1024 + cc] = w[3]; }
        __syncthreads();
        f32x4 gg[4];
#pragma unroll
        for (int j = 0; j < 4; ++j) gg[j] = *((const f32x4*)args.in[10] + lane + 64 * j);
        u32x2 nxw[4][4];
#pragma unroll
        for (int rr = 0; rr < 4; ++rr) { const int row = (gw + rr * NGW < T) ? gw + rr * NGW : gw;
#pragma unroll
            for (int j = 0; j < 4; ++j) nxw[rr][j] = *((const u32x2*)(X1B + (size_t)row * D) + lane + 64 * j); }
        for (int row0 = gw; row0 < T; row0 += 4 * NGW) {
            f32x4 v[4][4]; float ss[4];
#pragma unroll
            for (int rr = 0; rr < 4; ++rr) {
#pragma unroll
                for (int j = 0; j < 4; ++j) { const u32x2 xw = nxw[rr][j]; v[rr][j] = (f32x4){bf_lo(xw.x), bf_hi(xw.x), bf_lo(xw.y), bf_hi(xw.y)}; } }
            { const int rown0 = (row0 + 4 * NGW < T) ? row0 + 4 * NGW : row0;
#pragma unroll
              for (int rr = 0; rr < 4; ++rr) { const int row = (rown0 + rr * NGW < T) ? rown0 + rr * NGW : rown0;
#pragma unroll
                  for (int j = 0; j < 4; ++j) nxw[rr][j] = *((const u32x2*)(X1B + (size_t)row * D) + lane + 64 * j); } }
#pragma unroll
            for (int rr = 0; rr < 4; ++rr) { float a = 0.f;
#pragma unroll
                for (int j = 0; j < 4; ++j) a += (v[rr][j].x * v[rr][j].x + v[rr][j].y * v[rr][j].y) + (v[rr][j].z * v[rr][j].z + v[rr][j].w * v[rr][j].w);
                ss[rr] = a; }
#pragma unroll
            for (int o = 1; o < 64; o <<= 1) {
#pragma unroll
                for (int rr = 0; rr < 4; ++rr) ss[rr] += __shfl_xor(ss[rr], o); }
#pragma unroll
            for (int rr = 0; rr < 4; ++rr) { const int row = row0 + rr * NGW; const float r = 1.0f / sqrtf(ss[rr] * (1.0f / D) + EPS);
#pragma unroll
                for (int j = 0; j < 4; ++j) { v[rr][j] = v[rr][j] * r * gg[j];
                    if (row < T) { u32x2 w; w.x = cvt_pk_bf16(v[rr][j][0], v[rr][j][1]); w.y = cvt_pk_bf16(v[rr][j][2], v[rr][j][3]); *((u32x2*)(H2 + (size_t)row * D) + lane + 64 * j) = w; } } }
            float val[64];
#pragma unroll
            for (int e = 0; e < 16; ++e) { float a0 = 0.f, a1 = 0.f, a2 = 0.f, a3 = 0.f;
#pragma unroll
                for (int j = 0; j < 4; ++j) { const f32x4 w = *(const LAS f32x4*)(wrt + e * 1024 + 4 * lane + 256 * j);
                    a0 += (v[0][j][0] * w[0] + v[0][j][1] * w[1]) + (v[0][j][2] * w[2] + v[0][j][3] * w[3]); a1 += (v[1][j][0] * w[0] + v[1][j][1] * w[1]) + (v[1][j][2] * w[2] + v[1][j][3] * w[3]);
                    a2 += (v[2][j][0] * w[0] + v[2][j][1] * w[1]) + (v[2][j][2] * w[2] + v[2][j][3] * w[3]); a3 += (v[3][j][0] * w[0] + v[3][j][1] * w[1]) + (v[3][j][2] * w[2] + v[3][j][3] * w[3]); }
                val[e] = a0; val[16 + e] = a1; val[32 + e] = a2; val[48 + e] = a3; }
#pragma unroll
            for (int off = 32, n = 64; off >= 1; off >>= 1, n >>= 1) { const bool up = (lane & off) != 0;
#pragma unroll
                for (int k = 0; k < n / 2; ++k) { const float a = val[k], bq = val[k + n / 2]; const float send = up ? a : bq, keep = up ? bq : a; val[k] = keep + __shfl_xor(send, off); } }
            const float lg = val[0];
            float mx = lg;
#pragma unroll
            for (int o = 8; o >= 1; o >>= 1) mx = fmaxf(mx, __shfl_xor(mx, o));
            const float pe = __expf(lg - mx); float den = pe;
#pragma unroll
            for (int o = 8; o >= 1; o >>= 1) den += __shfl_xor(den, o);
            const int row = row0 + (lane >> 4) * NGW;
            if (row < T) AFF[((size_t)(row >> 12) * NE + (lane & 15)) * SEQ + (row & (SEQ - 1))] = pe / den;
        }
    }
    SEAM(5);

    STAMP_AT(6);
    if (IN(6)) {
        for (int item = vcu; item < 256; item += G) {
            const int be = item >> 2, qtr = item & 3, b = be >> 4, e = be & 15;
            LAS int* wsum = (LAS int*)lds;
            LAS int* idxl = (LAS int*)(lds + 256);
            __syncthreads();
            unsigned v[8];
            { const float* ap = AFF + (size_t)be * SEQ + 8 * tid; const f32x4 a0 = *(const f32x4*)ap, a1 = *(const f32x4*)(ap + 4);
#pragma unroll
              for (int i = 0; i < 4; ++i) { v[i] = __float_as_uint(a0[i]); v[4 + i] = __float_as_uint(a1[i]); } }
            unsigned prefix = 0u;
            for (int bit = 30; bit >= 0; --bit) {
                const unsigned cand = prefix | (1u << bit); int cnt = 0;
#pragma unroll
                for (int i = 0; i < 8; ++i) cnt += (v[i] >= cand) ? 1 : 0;
                cnt = wave_sum_i(cnt);
                if (lane == 0) wsum[(bit & 1) * 8 + wave] = cnt;
                __syncthreads();
                int tot = 0;
#pragma unroll
                for (int w = 0; w < 8; ++w) tot += wsum[(bit & 1) * 8 + w];
                if (tot >= CAP) prefix = cand;
            }
            const unsigned tau = prefix;
            int cgt = 0, ceq = 0;
#pragma unroll
            for (int i = 0; i < 8; ++i) { cgt += (v[i] > tau) ? 1 : 0; ceq += (v[i] == tau) ? 1 : 0; }
            int sce = ceq;
#pragma unroll
            for (int o = 1; o < 64; o <<= 1) { const int y = __shfl_up(sce, o); if (lane >= o) sce += y; }
            const int wgt = wave_sum_i(cgt);
            if (lane == 63) wsum[16 + wave] = sce;
            if (lane == 0) wsum[24 + wave] = wgt;
            __syncthreads();
            int ngt = 0, eqbase = sce - ceq;
#pragma unroll
            for (int w = 0; w < 8; ++w) { ngt += wsum[24 + w]; eqbase += (w < wave) ? wsum[16 + w] : 0; }
            const int need = CAP - ngt;
            unsigned selm = 0u; int nsel = 0, er = eqbase;
#pragma unroll
            for (int i = 0; i < 8; ++i) { bool sel = v[i] > tau; if (v[i] == tau) { sel = er < need; ++er; } if (sel) { selm |= (1u << i); ++nsel; } }
            int scs = nsel;
#pragma unroll
            for (int o = 1; o < 64; o <<= 1) { const int y = __shfl_up(scs, o); if (lane >= o) scs += y; }
            if (lane == 63) wsum[32 + wave] = scs;
            __syncthreads();
            int slot = scs - nsel;
#pragma unroll
            for (int w = 0; w < 8; ++w) slot += (w < wave) ? wsum[32 + w] : 0;
            const bool wr_slot = (tid >> 7) == qtr;
#pragma unroll
            for (int i = 0; i < 8; ++i) { const int tok = 8 * tid + i; const bool sel = (selm >> i) & 1u;
                if (sel && (slot >> 7) == qtr) { GATE[(size_t)(e * NB + b) * CAP + slot] = __uint_as_float(v[i]); ROWTOK[(size_t)(e * NB + b) * CAP + slot] = b * SEQ + tok; }
                if (wr_slot) SLOT[((size_t)b * SEQ + tok) * NE + e] = sel ? (short)slot : (short)-1;
                if (sel) ++slot; }
            (void)idxl;
        }
    }
    STAMP_AT(106);
    SEAM(6);

    STAMP_AT(7);
    if (IN(7)) {
        pg8::Gemm g{H2, WGU, MROWS, 2 * EH, D, ROWTOK}; pg8::StaticOrder S; S.init(MROWS, 2 * EH, G, bx, 3);
        pg8::EpiSwiGLU E{ACT};
        pg8::gemm_phase<pg8::EpiSwiGLU, true, true, true>(lds, g, S, E);
    }
    SEAM(7);

    STAMP_AT(8);
    if (IN(8)) {
        pg8::Gemm g{ACT, WDT, MROWS, D, EH, nullptr}; pg8::StaticOrder S; S.init(MROWS, D, G, bx, 3);
        pg8::EpiDown E{YB, GATE};
        pg8::gemm_phase<pg8::EpiDown>(lds, g, S, E);
    }
    STAMP_AT(108);
    SEAM(8);

    STAMP_AT(9);
    if (IN(9)) {
        f32x4 gg[4];
#pragma unroll
        for (int j = 0; j < 4; ++j) gg[j] = *((const f32x4*)args.in[15] + lane + 64 * j);
        u32x2 nx9[4]; u32x4 ns0, ns1;
#pragma unroll
        for (int j = 0; j < 4; ++j) nx9[j] = *((const u32x2*)(X1B + (size_t)gw * D) + lane + 64 * j);
        ns0 = *(const u32x4*)(SLOT + (size_t)gw * NE); ns1 = *(const u32x4*)(SLOT + (size_t)gw * NE + 8);
        for (int row = gw; row < T; row += NGW) {
            const int b = row >> 12; const int rn = (row + NGW < T) ? row + NGW : row;
            f32x4 v[4];
#pragma unroll
            for (int j = 0; j < 4; ++j) v[j] = (f32x4){bf_lo(nx9[j].x), bf_hi(nx9[j].x), bf_lo(nx9[j].y), bf_hi(nx9[j].y)};
            const u32x4 s0 = ns0, s1 = ns1;
#pragma unroll
            for (int j = 0; j < 4; ++j) nx9[j] = *((const u32x2*)(X1B + (size_t)rn * D) + lane + 64 * j);
            ns0 = *(const u32x4*)(SLOT + (size_t)rn * NE); ns1 = *(const u32x4*)(SLOT + (size_t)rn * NE + 8);
#pragma unroll
            for (int e = 0; e < 16; ++e) { const unsigned w = (e < 8) ? s0[(e & 7) >> 1] : s1[(e & 7) >> 1]; int sl = (int)(short)((e & 1) ? (w >> 16) : (w & 0xffffu)); sl = __builtin_amdgcn_readfirstlane(sl);
                if (sl >= 0) { const bf16_t* yp = YB + ((size_t)(e * NB + b) * CAP + sl) * D + 4 * lane;
#pragma unroll
                    for (int j = 0; j < 4; ++j) { const u32x2 yw = __builtin_nontemporal_load((const u32x2*)(yp + 256 * j)); v[j][0] += bf_lo(yw.x); v[j][1] += bf_hi(yw.x); v[j][2] += bf_lo(yw.y); v[j][3] += bf_hi(yw.y); } } }
            float s = 0.f;
#pragma unroll
            for (int j = 0; j < 4; ++j) s += (v[j].x * v[j].x + v[j].y * v[j].y) + (v[j].z * v[j].z + v[j].w * v[j].w);
            const float r = 1.0f / sqrtf(wave_sum(s) * (1.0f / D) + EPS);
#pragma unroll
            for (int j = 0; j < 4; ++j) __builtin_nontemporal_store(v[j] * r * gg[j], (f32x4*)(OUT + (size_t)row * D) + lane + 64 * j);
        }
    }
    STAMP_AT(10);
#ifdef STAMP_LO
    if (bx == STAMP_BLK && tid == 0) { const unsigned long long t0 = __builtin_amdgcn_s_memrealtime(), want = (ts1 - ts0) * STAMP_AMP; while (__builtin_amdgcn_s_memrealtime() - t0 < want) __builtin_amdgcn_s_sleep(8); }
#endif
#undef IN
#undef SEAM
}

extern "C" void kernel_launch(void* const* d_in, const int* in_sizes, int n_in, void* d_out, int out_size, void* d_ws, size_t ws_size, hipStream_t stream) {
    static int grid = 0;
    if (grid == 0) {
        if (n_in != 16 || in_sizes[0] != T * D || out_size != T * D || ws_size < WS_END) { fprintf(stderr, "kernel_launch: unexpected shapes (n_in %d, in0 %d, out %d, ws %zu < %zu)\n", n_in, n_in > 0 ? in_sizes[0] : -1, out_size, ws_size, (size_t)WS_END); grid = -1; return; }
        int dev = 0, cus = 0, per_cu = 0;
        if (hipGetDevice(&dev) != hipSuccess || hipDeviceGetAttribute(&cus, hipDeviceAttributeMultiprocessorCount, dev) != hipSuccess) { grid = -1; return; }
        if (hipFuncSetAttribute((const void*)mk_fwd, hipFuncAttributeMaxDynamicSharedMemorySize, LDS_BYTES) != hipSuccess) { fprintf(stderr, "kernel_launch: hipFuncSetAttribute failed\n"); grid = -1; return; }
        if (hipOccupancyMaxActiveBlocksPerMultiprocessor(&per_cu, (const void*)mk_fwd, NWAVES * 64, LDS_BYTES) != hipSuccess || per_cu < 1) { fprintf(stderr, "kernel_launch: occupancy query says %d blocks/CU\n", per_cu); per_cu = 1; }
        (void)hipGetLastError();
        grid = cus;
    }
    if (grid < 0) return;
    (void)hipMemsetAsync((char*)d_ws + WS_CTL, 0, 1 * MiB, stream);
    Args a{};
    for (int i = 0; i < 16; ++i) a.in[i] = (const float*)d_in[i];
    a.out = (float*)d_out; a.ws = (unsigned char*)d_ws;
#if MK_MODE == 0
    for (int p = 0; p < NPH; ++p) { a.ph_lo = p; a.ph_hi = p + 1; hipLaunchKernelGGL(mk_fwd, dim3(grid), dim3(NWAVES * 64), LDS_BYTES, stream, a); }
#elif MK_MODE == 1
    a.ph_lo = 0; a.ph_hi = NPH;
    void* kargs[] = {&a};
    hipError_t e = hipLaunchCooperativeKernel((const void*)mk_fwd, dim3(grid), dim3(NWAVES * 64), kargs, LDS_BYTES, stream);
    if (e != hipSuccess) fprintf(stderr, "kernel_launch: cooperative launch failed: %s\n", hipGetErrorString(e));
#else
    a.ph_lo = 0; a.ph_hi = NPH;
    hipLaunchKernelGGL(mk_fwd, dim3(grid), dim3(NWAVES * 64), LDS_BYTES, stream, a);
#endif
}
```

```cpp
#include <hip/hip_runtime.h>
#include <hip/hip_cooperative_groups.h>
#include <cstdio>
#include <cstdint>

#ifndef MK_MODE
#define MK_MODE 2
#endif

#ifndef STAMP_AMP
#define STAMP_AMP 4
#endif
#ifndef STAMP_BLK
#define STAMP_BLK 0
#endif
#define LAS __attribute__((address_space(3)))
typedef unsigned short bf16_t;
typedef short bf16x8 __attribute__((ext_vector_type(8)));
typedef short s16x4 __attribute__((ext_vector_type(4)));
typedef float f32x2 __attribute__((ext_vector_type(2)));
typedef float f32x4 __attribute__((ext_vector_type(4)));
typedef float f32x16 __attribute__((ext_vector_type(16)));
typedef unsigned u32x2 __attribute__((ext_vector_type(2)));
typedef unsigned u32x4 __attribute__((ext_vector_type(4)));

constexpr int NB = 4, SEQ = 4096, T = NB * SEQ, D = 1024;
constexpr int GW = 512, AW = 512, NH = 8, HD = 64;
constexpr int INC = 2 * GW + 3 * AW + 2 * D;
constexpr int P1W = 2 * GW;
constexpr int GTW = 2 * D;
constexpr int NE = 16, EH = 1024, CAP = 512;
constexpr int MROWS = NE * NB * CAP;
constexpr float EPS = 1e-6f;
constexpr float LOG2E = 1.4426950408889634f;
constexpr int NPH = 10;

constexpr size_t MiB = 1u << 20;
constexpr size_t WS_CTL = 0;
constexpr size_t WS_WSP = 1 * MiB;
constexpr size_t WS_GATE = 1 * MiB + 512 * 1024;
constexpr size_t WS_ROWTOK = 1 * MiB + 768 * 1024;
constexpr size_t WS_SLOT = 2 * MiB;
constexpr size_t WS_AFF = 3 * MiB;
constexpr size_t WS_PAT = 5 * MiB;
constexpr size_t WS_WOT = 7 * MiB;
constexpr size_t WS_WGU = 9 * MiB;
constexpr size_t WS_WDT = 73 * MiB;
constexpr size_t WS_P1 = 105 * MiB;
constexpr size_t WS_QH = 137 * MiB, WS_KH = 153 * MiB, WS_VH = 169 * MiB;
constexpr size_t WS_MG = 105 * MiB;
constexpr size_t WS_ACT = 105 * MiB;
constexpr size_t WS_Y = 169 * MiB;
constexpr size_t WS_GT = 185 * MiB;
constexpr size_t WS_H2 = 201 * MiB;
constexpr size_t WS_H = 249 * MiB;
constexpr size_t WS_A = 249 * MiB;
constexpr size_t WS_X1 = 249 * MiB;
constexpr size_t WS_END = 281 * MiB;
constexpr int SCR_STRIDE = 68;

__device__ __forceinline__ unsigned cvt_pk_bf16(float lo, float hi) { unsigned r; asm volatile("v_cvt_pk_bf16_f32 %0, %1, %2" : "=v"(r) : "v"(lo), "v"(hi)); return r; }
typedef __bf16 bf16x2_t __attribute__((ext_vector_type(2)));
__device__ __forceinline__ unsigned cvt_pk_fast(float lo, float hi) { const f32x2 v = {lo, hi}; const bf16x2_t b = __builtin_convertvector(v, bf16x2_t); return __builtin_bit_cast(unsigned, b); }
__device__ __forceinline__ float bf_lo(unsigned w) { return __uint_as_float(w << 16); }
__device__ __forceinline__ float bf_hi(unsigned w) { return __uint_as_float(w & 0xffff0000u); }
__device__ __forceinline__ float wave_sum(float v) {
#pragma unroll
    for (int o = 1; o < 64; o <<= 1) v += __shfl_xor(v, o);
    return v;
}
__device__ __forceinline__ int wave_sum_i(int v) {
#pragma unroll
    for (int o = 1; o < 64; o <<= 1) v += __shfl_xor(v, o);
    return v;
}
__device__ __forceinline__ float fast_sigmoid(float y) { return __builtin_amdgcn_rcpf(1.0f + __builtin_amdgcn_exp2f(-LOG2E * y)); }
__device__ __forceinline__ float gelu_tanh(float x) {
    const float z = 0.7978845608028654f * (x + 0.044715f * x * x * x);
    return x * __builtin_amdgcn_rcpf(1.0f + __builtin_amdgcn_exp2f(-2.0f * LOG2E * z));
}

namespace pg8 {
constexpr int BM = 256, BK = 64, HALF = 128, HTB = HALF * BK * 2, STAGE_BYTES = 8 * HTB, NXCD = 8, WGM = 8;
__host__ __device__ __forceinline__ int lds_byte(int r, int c) { const int st = (r >> 4) * 2 + (c >> 5), rr = r & 15, cc = c & 31, ob = rr * 64 + cc * 2; return st * 1024 + (ob ^ (((ob >> 9) & 1) << 5)); }
__host__ __device__ __forceinline__ void stage_rc(int b, int& R, int& C) { const int st = b / 1024, sb = b % 1024, swz = sb ^ (((sb >> 9) & 1) << 5); R = (st >> 1) * 16 + swz / 64; C = (st & 1) * 32 + (swz % 64) / 2; }
__host__ __device__ __forceinline__ int perm32(int rho) { const int n = rho >> 4, i = rho & 15; return 8 * (i >> 2) + 4 * n + (i & 3); }

struct Unit { int pm, pn; };
struct Gemm { const bf16_t* A; const bf16_t* Bt; int M, N, K; const int* rowtok; };

struct StaticOrder {
    int nM, nN, nwg, G, c, gsh, N, ibeg, iend;
    __device__ void init(int M, int N_, int G_, int c_, int gsh_, int ibeg_ = 0, int iend_ = 1 << 20) { nM = M / BM; nN = N_ / BM; nwg = nM * nN; G = G_; c = c_; gsh = gsh_; N = N_; ibeg = ibeg_; iend = iend_; }
    __device__ bool next(int i, Unit& u) const {
        if (i + ibeg >= iend) return false;
        const long L = (long)(i + ibeg) * G + c; if (L >= nwg) return false;
        int wgid = (int)L; { const int q = nwg / NXCD, r = nwg % NXCD, xcd = wgid % NXCD, off = wgid / NXCD; wgid = (xcd < r ? xcd * (q + 1) : r * (q + 1) + (xcd - r) * q) + off; }
        const int nig = WGM * nN, gid = wgid / nig, fm = gid * WGM, gsz = (nM - fm) < WGM ? (nM - fm) : WGM;
        u.pm = fm + ((wgid % nig) % gsz); u.pn = (wgid % nig) / gsz; return true;
    }
    __device__ __forceinline__ int brow(const Unit& u) const { return (gsh >= 0 ? (u.pm >> gsh) * N : 0) + u.pn * BM; }
};

template <class Epi, bool ALIGN_EPI = true, bool SP2 = true, bool GATHER = false>
__device__ __forceinline__ void gemm_phase(LAS unsigned char* lds, const Gemm g, const StaticOrder& S, const Epi& E) {
    static_assert(!GATHER || SP2, "the gathered A operand is implemented for the SP2 loop");
    const int tid = threadIdx.x, wid = __builtin_amdgcn_readfirstlane(tid >> 6), lane = tid & 63, wr = wid >> 2, wc = wid & 3, fr = lane & 15, fq = lane >> 4;
    const int K = g.K, nt = K / BK;
    unsigned voffA[2], voffB[2];
#pragma unroll
    for (int i = 0; i < 2; ++i) { int R, C; stage_rc(tid * 16 + i * 8192, R, C); const int Rb = Epi::PERM ? ((R & ~31) + perm32(R & 31)) : R;
        voffA[i] = (unsigned)(R * K + C) * 2u; voffB[i] = (unsigned)(Rb * K + C) * 2u; }
    const size_t kstep = (size_t)(BK * 2);
    const size_t hstep = (size_t)HALF * K * 2;
    const size_t tstep = 2 * hstep;
    const size_t rstep = (size_t)K * 2;
    const unsigned ldsw = (unsigned)wid * 1024u;
    const int aoff = lds_byte(wr * 64 + fr, fq * 8), boff = lds_byte(wc * 32 + fr, fq * 8);
#define PG8_SA(b, h) (((b) * 2 + (h)) * HTB)
#define PG8_SB(b, h) ((4 + (b) * 2 + (h)) * HTB)
#define PG8_STAGE(bufoff, gbase, voff) do { _Pragma("unroll") for (int _i = 0; _i < 2; ++_i) \
        __builtin_amdgcn_global_load_lds((const unsigned*)((const char*)(gbase) + (voff)[_i]), (LAS unsigned*)(lds + (bufoff) + ldsw + _i * 8192), 16, 0, 0); } while (0)
#define PG8_LDA(dst, b, h) do { _Pragma("unroll") for (int m = 0; m < 4; ++m) _Pragma("unroll") for (int k = 0; k < 2; ++k) dst[m][k] = *(const LAS bf16x8*)(lds + PG8_SA(b, h) + aoff + m * 2048 + k * 1024); } while (0)
#define PG8_LDB(dst, b, h) do { _Pragma("unroll") for (int n = 0; n < 2; ++n) _Pragma("unroll") for (int k = 0; k < 2; ++k) dst[n][k] = *(const LAS bf16x8*)(lds + PG8_SB(b, h) + boff + n * 2048 + k * 1024); } while (0)
#define PG8_MMA(ai, bj, At, Bt) do { __builtin_amdgcn_s_setprio(1); _Pragma("unroll") for (int m = 0; m < 4; ++m) _Pragma("unroll") for (int n = 0; n < 2; ++n) _Pragma("unroll") for (int k = 0; k < 2; ++k) \
        acc[ai][bj][m][n] = __builtin_amdgcn_mfma_f32_16x16x32_bf16(Bt[n][k], At[m][k], acc[ai][bj][m][n], 0, 0, 0); __builtin_amdgcn_s_setprio(0); } while (0)
#define PG8_WAIT_V(n) asm volatile("s_waitcnt vmcnt(" #n ")" ::: "memory")
#define PG8_WAIT_L(n) asm volatile("s_waitcnt lgkmcnt(" #n ")" ::: "memory")
#define PG8_BAR __builtin_amdgcn_s_barrier()
#define PG8_SCHED __builtin_amdgcn_sched_barrier(0)
    unsigned gAc[2][2], gAn[2][2];
#define PG8_GOFF(dst, u) do { if constexpr (GATHER) { _Pragma("unroll") for (int _h = 0; _h < 2; ++_h) _Pragma("unroll") for (int _i = 0; _i < 2; ++_i) { int R_, C_; stage_rc(tid * 16 + _i * 8192, R_, C_); \
        dst[_h][_i] = (unsigned)g.rowtok[(u).pm * BM + _h * HALF + R_] * (unsigned)(K * 2) + (unsigned)(C_ * 2); } } } while (0)
#define PG8_STAGEA(bufoff, SEL, H, KT) do { if constexpr (GATHER) { const char* _b = (const char*)g.A + (size_t)(KT) * kstep; \
        _Pragma("unroll") for (int _i = 0; _i < 2; ++_i) __builtin_amdgcn_global_load_lds((const unsigned*)(_b + ((SEL) ? gAn[H][_i] : gAc[H][_i])), (LAS unsigned*)(lds + (bufoff) + ldsw + _i * 8192), 16, 0, 0); } \
        else { const char* _b = ((SEL) ? nA : cA) + (size_t)(H) * hstep + (size_t)(KT) * kstep; PG8_STAGE(bufoff, _b, voffA); } } while (0)
    Unit cur, nxt; int ui = 0;
    if (!S.next(0, cur)) return;
    PG8_GOFF(gAc, cur);
    f32x4 acc[2][2][4][2];
#pragma unroll
    for (int a = 0; a < 2; ++a)
#pragma unroll
        for (int b = 0; b < 2; ++b)
#pragma unroll
            for (int m = 0; m < 4; ++m)
#pragma unroll
                for (int n = 0; n < 2; ++n) acc[a][b][m][n] = (f32x4){0.f, 0.f, 0.f, 0.f};
    bf16x8 At[4][2], B0[2][2], B1[2][2];
    const char* cA = (const char*)g.A + (size_t)cur.pm * tstep; const char* cB = (const char*)g.Bt + (size_t)S.brow(cur) * rstep;
    const char* nA = cA;
    if constexpr (SP2) {
        PG8_STAGE(PG8_SB(0, 0), cB, voffB); PG8_STAGE(PG8_SB(0, 1), cB + hstep, voffB); PG8_STAGEA(PG8_SA(0, 0), 0, 0, 0); PG8_STAGEA(PG8_SA(0, 1), 0, 1, 0);
        if (wr == 1) PG8_BAR;
        PG8_WAIT_V(2); PG8_BAR;
        PG8_STAGE(PG8_SB(1, 0), cB + kstep, voffB); PG8_STAGEA(PG8_SA(1, 0), 0, 0, 1); PG8_STAGE(PG8_SB(1, 1), cB + hstep + kstep, voffB);
        PG8_WAIT_V(6); PG8_BAR;
    } else {
        PG8_STAGE(PG8_SB(0, 0), cB, voffB); PG8_STAGE(PG8_SA(0, 0), cA, voffA); PG8_STAGE(PG8_SB(0, 1), cB + hstep, voffB); PG8_STAGE(PG8_SA(0, 1), cA + hstep, voffA);
        if (wr == 1) PG8_BAR;
        PG8_WAIT_V(4); PG8_BAR;
        PG8_STAGE(PG8_SB(1, 0), cB + kstep, voffB); PG8_STAGE(PG8_SA(1, 0), cA + kstep, voffA); PG8_STAGE(PG8_SB(1, 1), cB + hstep + kstep, voffB);
        PG8_WAIT_V(6); PG8_BAR;
    }
    for (;;) {
        const bool has_next = S.next(ui + 1, nxt);
        nA = has_next ? (const char*)g.A + (size_t)nxt.pm * tstep : cA; const char* nB = has_next ? (const char*)g.Bt + (size_t)S.brow(nxt) * rstep : cB;
        if constexpr (GATHER) { if (has_next) PG8_GOFF(gAn, nxt); else {
#pragma unroll
            for (int _h = 0; _h < 2; ++_h)
#pragma unroll
                for (int _i = 0; _i < 2; ++_i) gAn[_h][_i] = gAc[_h][_i]; } }
        for (int t = 0; t < nt; t += 2) {
            const bool last = (t == nt - 2);
            if constexpr (Epi::MIDK) { if (t == E.midt(nt)) E.mid(acc, cur, wr, wc, fr, fq); }
            const char* a1 = cA + (size_t)(t + 1) * kstep;
            const char* a2 = last ? nA : cA + (size_t)(t + 2) * kstep; const char* b2 = last ? nB : cB + (size_t)(t + 2) * kstep;
            const char* a3 = a2 + kstep; const char* b3 = b2 + kstep;
            if constexpr (SP2) {
            const int sel2 = last ? 1 : 0, kt2 = last ? 0 : t + 2;
            PG8_LDB(B0, 0, 0); PG8_LDB(B1, 0, 1); PG8_SCHED; PG8_LDA(At, 0, 0); PG8_STAGEA(PG8_SA(1, 1), 0, 1, t + 1);
            PG8_WAIT_V(8); PG8_WAIT_L(0); PG8_BAR; PG8_MMA(0, 0, At, B0); PG8_MMA(0, 1, At, B1); PG8_BAR; PG8_SCHED;
            PG8_LDA(At, 0, 1); PG8_STAGE(PG8_SB(0, 0), b2, voffB); PG8_STAGE(PG8_SB(0, 1), b2 + hstep, voffB); PG8_STAGEA(PG8_SA(0, 0), sel2, 0, kt2);
            PG8_WAIT_V(8); PG8_WAIT_L(0); PG8_BAR; PG8_MMA(1, 0, At, B0); PG8_MMA(1, 1, At, B1); PG8_BAR; PG8_SCHED;
            PG8_LDB(B0, 1, 0); PG8_LDB(B1, 1, 1); PG8_SCHED; PG8_LDA(At, 1, 0); PG8_STAGEA(PG8_SA(0, 1), sel2, 1, kt2);
            PG8_WAIT_V(8); PG8_WAIT_L(0); PG8_BAR; PG8_MMA(0, 0, At, B0); PG8_MMA(0, 1, At, B1); PG8_BAR; PG8_SCHED;
            PG8_LDA(At, 1, 1); PG8_STAGE(PG8_SB(1, 0), b3, voffB); PG8_STAGE(PG8_SB(1, 1), b3 + hstep, voffB); PG8_STAGEA(PG8_SA(1, 0), sel2, 0, kt2 + 1);
            PG8_WAIT_V(8); PG8_WAIT_L(0); PG8_BAR; PG8_MMA(1, 0, At, B0); PG8_MMA(1, 1, At, B1); PG8_BAR; PG8_SCHED;
            } else {
            PG8_LDB(B0, 0, 0); PG8_SCHED; PG8_LDA(At, 0, 0); PG8_STAGE(PG8_SA(1, 1), a1 + hstep, voffA);
            PG8_WAIT_L(8); PG8_BAR; PG8_WAIT_L(0); PG8_MMA(0, 0, At, B0); PG8_BAR; PG8_SCHED;
            PG8_LDB(B1, 0, 1); PG8_STAGE(PG8_SB(0, 0), b2, voffB);
            PG8_BAR; PG8_WAIT_L(0); PG8_MMA(0, 1, At, B1); PG8_BAR;
            PG8_LDA(At, 0, 1); PG8_STAGE(PG8_SA(0, 0), a2, voffA);
            PG8_BAR; PG8_WAIT_L(0); PG8_MMA(1, 0, At, B0); PG8_BAR; PG8_SCHED;
            PG8_STAGE(PG8_SB(0, 1), b2 + hstep, voffB);
            PG8_WAIT_V(6); PG8_BAR; PG8_MMA(1, 1, At, B1); PG8_BAR;
            PG8_LDB(B0, 1, 0); PG8_SCHED; PG8_LDA(At, 1, 0); PG8_STAGE(PG8_SA(0, 1), a2 + hstep, voffA);
            PG8_WAIT_L(8); PG8_BAR; PG8_WAIT_L(0); PG8_MMA(0, 0, At, B0); PG8_BAR; PG8_SCHED;
            PG8_LDB(B1, 1, 1); PG8_STAGE(PG8_SB(1, 0), b3, voffB);
            PG8_BAR; PG8_WAIT_L(0); PG8_MMA(0, 1, At, B1); PG8_BAR;
            PG8_LDA(At, 1, 1); PG8_STAGE(PG8_SA(1, 0), a3, voffA);
            PG8_BAR; PG8_WAIT_L(0); PG8_MMA(1, 0, At, B0); PG8_BAR; PG8_SCHED;
            PG8_STAGE(PG8_SB(1, 1), b3 + hstep, voffB);
            PG8_WAIT_V(6); PG8_BAR; PG8_MMA(1, 1, At, B1); PG8_BAR;
            }
        }
        if constexpr (ALIGN_EPI) { if (wr == 0) PG8_BAR; }
        E(acc, cur, wr, wc, fr, fq);
        if (!has_next) break;
#pragma unroll
        for (int a = 0; a < 2; ++a)
#pragma unroll
            for (int b = 0; b < 2; ++b)
#pragma unroll
                for (int m = 0; m < 4; ++m)
#pragma unroll
                    for (int n = 0; n < 2; ++n) acc[a][b][m][n] = (f32x4){0.f, 0.f, 0.f, 0.f};
        cur = nxt; cA = nA; cB = nB; ++ui;
        if constexpr (GATHER) {
#pragma unroll
            for (int _h = 0; _h < 2; ++_h)
#pragma unroll
                for (int _i = 0; _i < 2; ++_i) gAc[_h][_i] = gAn[_h][_i]; }
        if constexpr (ALIGN_EPI) { if (wr == 1) PG8_BAR; }
    }
    PG8_WAIT_V(0);
    if constexpr (!ALIGN_EPI) { if (wr == 0) PG8_BAR; }
    PG8_BAR;
#undef PG8_SA
#undef PG8_SB
#undef PG8_STAGE
#undef PG8_STAGEA
#undef PG8_GOFF
#undef PG8_LDA
#undef PG8_LDB
#undef PG8_MMA
#undef PG8_WAIT_V
#undef PG8_WAIT_L
#undef PG8_BAR
#undef PG8_SCHED
}

typedef const f32x4 (&AccRef)[2][2][4][2];
typedef f32x4 (&AccMut)[2][2][4][2];

struct EpiProj {
    static constexpr bool PERM = true, MIDK = false;
    bf16_t* UV; bf16_t* QKV; bf16_t* GT; const float* bgate;
    __device__ __forceinline__ void operator()(AccRef acc, const Unit& u, int wr, int wc, int fr, int fq) const {
        const int pn = u.pn, row0 = u.pm * BM + wr * 64 + fr, cl = wc * 32 + 8 * fq;
        const bool isg = pn >= 10, ishm = pn >= 4 && pn < 10;
        const int mode = isg ? 3 : (pn < 4 ? 1 : (pn < 6 ? 2 : 0));
        f32x4 bv[2][2];
#pragma unroll
        for (int bj = 0; bj < 2; ++bj)
#pragma unroll
            for (int n = 0; n < 2; ++n) bv[bj][n] = isg ? *(const f32x4*)(bgate + (pn - 10) * 256 + bj * HALF + cl + 4 * n) : (f32x4){0.f, 0.f, 0.f, 0.f};
#pragma unroll
        for (int ai = 0; ai < 2; ++ai)
#pragma unroll
            for (int m = 0; m < 4; ++m) { const int row = row0 + ai * HALF + m * 16;
#pragma unroll
                for (int bj = 0; bj < 2; ++bj) { f32x4 v0 = acc[ai][bj][m][0], v1 = acc[ai][bj][m][1];
                    if (mode == 1) {
#pragma unroll
                        for (int j = 0; j < 4; ++j) { v0[j] = gelu_tanh(v0[j]); v1[j] = gelu_tanh(v1[j]); } }
                    else if (mode == 2) { v0 = v0 * (0.125f * LOG2E); v1 = v1 * (0.125f * LOG2E); }
                    else if (mode == 3) { v0 = v0 + bv[bj][0]; v1 = v1 + bv[bj][1];
#pragma unroll
                        for (int j = 0; j < 4; ++j) { v0[j] = fast_sigmoid(v0[j]); v1[j] = fast_sigmoid(v1[j]); } }
                    u32x4 w; w.x = cvt_pk_bf16(v0[0], v0[1]); w.y = cvt_pk_bf16(v0[2], v0[3]); w.z = cvt_pk_bf16(v1[0], v1[1]); w.w = cvt_pk_bf16(v1[2], v1[3]);
                    bf16_t* dst;
                    if (isg) dst = GT + (size_t)row * GTW + (pn - 10) * 256 + bj * HALF + cl;
                    else if (ishm) { const int col = ((pn - 4) & 1) * 256 + bj * HALF + cl;
                        dst = QKV + (size_t)((pn - 4) >> 1) * ((size_t)T * AW) + ((size_t)((row >> 12) * NH + (col >> 6)) * SEQ + (row & (SEQ - 1))) * HD + (col & 63); }
                    else dst = UV + (size_t)row * P1W + pn * 256 + bj * HALF + cl;
                    *(u32x4*)dst = w; } }
    }
};
struct EpiMerge {
    static constexpr bool PERM = true, MIDK = true;
    const bf16_t* GT; bf16_t* MG;
    __device__ __forceinline__ int midt(int nt) const { return nt / 2; }
    __device__ __forceinline__ void mid(AccMut acc, const Unit& u, int wr, int wc, int fr, int fq) const {
        asm volatile("" : "+v"(fr), "+v"(fq));
        const int row0 = u.pm * BM + wr * 64 + fr, col0 = u.pn * BM + wc * 32 + 8 * fq;
#pragma unroll
        for (int ai = 0; ai < 2; ++ai)
#pragma unroll
            for (int m = 0; m < 4; ++m) { const bf16_t* gp = GT + (size_t)(row0 + ai * HALF + m * 16) * GTW + col0;
#pragma unroll
                for (int bj = 0; bj < 2; ++bj) { const u32x4 ga = *(const u32x4*)(gp + bj * HALF), gb = *(const u32x4*)(gp + D + bj * HALF);
#pragma unroll
                    for (int j = 0; j < 2; ++j) { acc[ai][bj][m][0][2 * j] *= bf_lo(ga[j]) * __builtin_amdgcn_rcpf(fmaxf(bf_lo(gb[j]), 1e-18f)); acc[ai][bj][m][0][2 * j + 1] *= bf_hi(ga[j]) * __builtin_amdgcn_rcpf(fmaxf(bf_hi(gb[j]), 1e-18f));
                        acc[ai][bj][m][1][2 * j] *= bf_lo(ga[2 + j]) * __builtin_amdgcn_rcpf(fmaxf(bf_lo(gb[2 + j]), 1e-18f)); acc[ai][bj][m][1][2 * j + 1] *= bf_hi(ga[2 + j]) * __builtin_amdgcn_rcpf(fmaxf(bf_hi(gb[2 + j]), 1e-18f)); } }
                if (m == 3) asm volatile("" ::: "memory"); }
    }
    __device__ __forceinline__ void operator()(AccRef acc, const Unit& u, int wr, int wc, int fr, int fq) const {
        const int row0 = u.pm * BM + wr * 64 + fr, col0 = u.pn * BM + wc * 32 + 8 * fq;
#pragma unroll
        for (int ai = 0; ai < 2; ++ai)
#pragma unroll
            for (int m = 0; m < 4; ++m) { const size_t r = (size_t)(row0 + ai * HALF + m * 16);
#pragma unroll
                for (int bj = 0; bj < 2; ++bj) { const u32x4 gb = *(const u32x4*)(GT + r * GTW + D + col0 + bj * HALF); const f32x4 v0 = acc[ai][bj][m][0], v1 = acc[ai][bj][m][1];
                    u32x4 w; w.x = cvt_pk_bf16(v0[0] * fmaxf(bf_lo(gb[0]), 1e-18f), v0[1] * fmaxf(bf_hi(gb[0]), 1e-18f)); w.y = cvt_pk_bf16(v0[2] * fmaxf(bf_lo(gb[1]), 1e-18f), v0[3] * fmaxf(bf_hi(gb[1]), 1e-18f));
                    w.z = cvt_pk_bf16(v1[0] * fmaxf(bf_lo(gb[2]), 1e-18f), v1[1] * fmaxf(bf_hi(gb[2]), 1e-18f)); w.w = cvt_pk_bf16(v1[2] * fmaxf(bf_lo(gb[3]), 1e-18f), v1[3] * fmaxf(bf_hi(gb[3]), 1e-18f));
                    *(u32x4*)(MG + r * D + col0 + bj * HALF) = w; } }
    }
};
struct EpiResid {
    static constexpr bool PERM = false, MIDK = false;
    const float* X; bf16_t* X1;
    __device__ __forceinline__ void operator()(AccRef acc, const Unit& u, int wr, int wc, int fr, int fq) const {
        const int row0 = u.pm * BM + wr * 64 + fr, col0 = u.pn * BM + wc * 32 + 4 * fq;
#pragma unroll
        for (int ai = 0; ai < 2; ++ai)
#pragma unroll
            for (int m = 0; m < 4; ++m) { const size_t r = (size_t)(row0 + ai * HALF + m * 16);
#pragma unroll
                for (int bj = 0; bj < 2; ++bj)
#pragma unroll
                    for (int n = 0; n < 2; ++n) { const int c = col0 + bj * HALF + n * 16;
                        const f32x4 o = *(const f32x4*)(X + r * D + c) + acc[ai][bj][m][n];
                        u32x2 w; w.x = cvt_pk_bf16(o[0], o[1]); w.y = cvt_pk_bf16(o[2], o[3]); *(u32x2*)(X1 + r * D + c) = w; } }
    }
};
struct EpiSwiGLU {
    static constexpr bool PERM = true, MIDK = false;
    bf16_t* ACT;
    __device__ __forceinline__ void operator()(AccRef acc, const Unit& u, int wr, int wc, int fr, int fq) const {
        const int row0 = u.pm * BM + wr * 64 + fr, col0 = u.pn * HALF + wc * 32 + 8 * fq;
#pragma unroll
        for (int ai = 0; ai < 2; ++ai)
#pragma unroll
            for (int m = 0; m < 4; ++m) { bf16_t* rowp = ACT + (size_t)(row0 + ai * HALF + m * 16) * EH + col0;
                f32x4 o[2];
#pragma unroll
                for (int n = 0; n < 2; ++n) { const f32x4 gg = acc[ai][0][m][n], uu = acc[ai][1][m][n];
#pragma unroll
                    for (int j = 0; j < 4; ++j) o[n][j] = gg[j] * fast_sigmoid(gg[j]) * uu[j]; }
                u32x4 w; w.x = cvt_pk_bf16(o[0][0], o[0][1]); w.y = cvt_pk_bf16(o[0][2], o[0][3]); w.z = cvt_pk_bf16(o[1][0], o[1][1]); w.w = cvt_pk_bf16(o[1][2], o[1][3]);
                *(u32x4*)rowp = w; }
    }
};
struct EpiDown {
    static constexpr bool PERM = true, MIDK = false;
    bf16_t* Y; const float* gate;
    __device__ __forceinline__ void operator()(AccRef acc, const Unit& u, int wr, int wc, int fr, int fq) const {
        const int row0 = u.pm * BM + wr * 64 + fr, col0 = u.pn * BM + wc * 32 + 8 * fq;
#pragma unroll
        for (int ai = 0; ai < 2; ++ai)
#pragma unroll
            for (int m = 0; m < 4; ++m) { const int r = row0 + ai * HALF + m * 16; const float gt = gate[r]; bf16_t* rowp = Y + (size_t)r * D + col0;
#pragma unroll
                for (int bj = 0; bj < 2; ++bj) { const f32x4 v0 = acc[ai][bj][m][0] * gt, v1 = acc[ai][bj][m][1] * gt;
                    u32x4 w; w.x = cvt_pk_bf16(v0[0], v0[1]); w.y = cvt_pk_bf16(v0[2], v0[3]); w.z = cvt_pk_bf16(v1[0], v1[1]); w.w = cvt_pk_bf16(v1[2], v1[3]);
                    *(u32x4*)(rowp + bj * HALF) = w; } }
    }
};
}

#define XB_TMO      128
#define XB_XCNT(j)  (256  + 64 * (j))
#define XB_XSUB(j)  (1280 + 64 * (j))
#define XB_XGEN(j)  (2304 + 64 * (j))
#define XB_TOP      3328
#define XB_TOPGEN   3392
#define XCD_BAR_WORDS 3456
#define XB_SPIN_CAP (1u << 18)
__device__ __forceinline__ unsigned xb_ld(unsigned* p)              { return __hip_atomic_load(p, __ATOMIC_RELAXED, __HIP_MEMORY_SCOPE_AGENT); }
__device__ __forceinline__ unsigned xb_add(unsigned* p, unsigned v) { return __hip_atomic_fetch_add(p, v, __ATOMIC_RELAXED, __HIP_MEMORY_SCOPE_AGENT); }
__device__ __forceinline__ unsigned xb_xcc_id() { return (unsigned)__builtin_amdgcn_s_getreg((3 << 11) | 20) & 0xFu; }
#define XB_SPIN(cond, bar) do { unsigned _sp = 0; while (cond) { __builtin_amdgcn_s_sleep(1); \
    if ((++_sp & 255u) == 0u) { if (xb_ld(&(bar)[XB_TMO])) break; if (_sp > XB_SPIN_CAP) { atomicAdd(&(bar)[XB_TMO], 1u); break; } } } } while (0)
struct XcdBarrier { unsigned* bar; unsigned x; volatile LAS unsigned* st; };
__device__ __forceinline__ XcdBarrier xcd_barrier_post(unsigned* bar, volatile LAS unsigned* st) {
    XcdBarrier b; b.bar = bar; b.x = xb_xcc_id(); b.st = st;
    if (threadIdx.x == 0) (void)xb_add(&bar[XB_XCNT(b.x)], 1u);
    return b;
}
__device__ __forceinline__ void xcd_barrier_complete(unsigned* bar, unsigned x, unsigned& nloc, unsigned& nx) {
    const unsigned G = gridDim.x * gridDim.y * gridDim.z;
    unsigned sum, cnt, mine, sp = 0u;
    for (;;) {
        sum = 0u; cnt = 0u; mine = 0u;
#pragma unroll
        for (unsigned j = 0; j < 16; ++j) { const unsigned c = xb_ld(&bar[XB_XCNT(j)]); sum += c; cnt += (c > 0u) ? 1u : 0u; mine = (j == x) ? c : mine; }
        if (sum == G) break;
        __builtin_amdgcn_s_sleep(1);
        if ((++sp & 255u) == 0u) { if (xb_ld(&bar[XB_TMO])) break; if (sp > XB_SPIN_CAP) { atomicAdd(&bar[XB_TMO], 1u); break; } }
    }
    nloc = mine > 0u ? mine : 1u; nx = cnt > 0u ? cnt : 1u;
}
__device__ __forceinline__ void xcd_barrier(const XcdBarrier& b) {
    asm volatile("s_waitcnt vmcnt(0)" ::: "memory");
    __syncthreads();
    if (threadIdx.x == 0) {
        unsigned* bar = b.bar;
        __builtin_amdgcn_s_waitcnt(0);
        unsigned nloc = b.st[0], nx = b.st[1];
        if (nloc == 0u) { xcd_barrier_complete(bar, b.x, nloc, nx); b.st[0] = nloc; b.st[1] = nx; }
        const unsigned old = xb_add(&bar[XB_XSUB(b.x)], 1u);
        const unsigned gen = old / nloc;
        if (old + 1u == (gen + 1u) * nloc) {
            __builtin_amdgcn_fence(__ATOMIC_RELEASE, "agent");
            asm volatile("s_waitcnt vmcnt(0)" ::: "memory");
            const unsigned og = xb_add(&bar[XB_TOP], 1u);
            const unsigned tg = og / nx;
            if (og + 1u == (tg + 1u) * nx) xb_add(&bar[XB_TOPGEN], 1u);
            else XB_SPIN(xb_ld(&bar[XB_TOPGEN]) == tg, bar);
            __builtin_amdgcn_fence(__ATOMIC_ACQUIRE, "agent");
            xb_add(&bar[XB_XGEN(b.x)], 1u);
            asm volatile("s_waitcnt vmcnt(0)" ::: "memory");
        } else {
            XB_SPIN(xb_ld(&bar[XB_XGEN(b.x)]) == gen, bar);
            __builtin_amdgcn_fence(__ATOMIC_ACQUIRE, "agent");
            asm volatile("s_waitcnt vmcnt(0)" ::: "memory");
        }
    }
    __syncthreads();
}

constexpr int NWAVES = 8;
constexpr int LDS_BYTES = 147456;
constexpr int MISC_OFF = 144 * 1024 - 256;
constexpr int CW_BAR = 4096;

struct Args { const float* in[16]; float* out; unsigned char* ws; int ph_lo, ph_hi; };

struct TileRegs { f32x4 v[16]; };
__device__ __forceinline__ void tile_load(TileRegs& t, const float* W, int N, int k0, int n0, int lane) {
    const int n4 = (lane & 15) * 4, kq = lane >> 4;
#pragma unroll
    for (int i = 0; i < 16; ++i) t.v[i] = __builtin_nontemporal_load((const f32x4*)(W + (size_t)(k0 + 4 * i + kq) * N + n0 + n4));
}
__device__ __forceinline__ void tile_store(const TileRegs& t, int k0, bf16_t* WT, int Kd, int drow0, LAS float* scr, int lane) {
    const int n4 = (lane & 15) * 4, kq = lane >> 4;
#pragma unroll
    for (int i = 0; i < 16; ++i) { LAS float* s = scr + (4 * i + kq) * 65 + n4; s[0] = t.v[i][0]; s[1] = t.v[i][1]; s[2] = t.v[i][2]; s[3] = t.v[i][3]; }
    asm volatile("s_waitcnt lgkmcnt(0)" ::: "memory");
    const int c = lane & 7;
#pragma unroll
    for (int jj = 0; jj < 8; ++jj) { const int n = (lane >> 3) + 8 * jj; const LAS float* s = scr + (8 * c) * 65 + n;
        u32x4 o; o.x = cvt_pk_fast(s[0], s[65]); o.y = cvt_pk_fast(s[2 * 65], s[3 * 65]); o.z = cvt_pk_fast(s[4 * 65], s[5 * 65]); o.w = cvt_pk_fast(s[6 * 65], s[7 * 65]);
        __builtin_nontemporal_store(o, (u32x4*)(WT + (size_t)(drow0 + n) * Kd + k0 + 8 * c)); }
    asm volatile("s_waitcnt lgkmcnt(0)" ::: "memory");
}
__device__ __forceinline__ void transpose_tile(const float* W, int N, int k0, int n0, bf16_t* WT, int Kd, int drow0, LAS float* scr, int lane) {
    TileRegs t; tile_load(t, W, N, k0, n0, lane); tile_store(t, k0, WT, Kd, drow0, scr, lane);
}
struct ExTile { const float* W; int N, k0, n0; bf16_t* WT; int Kd, drow0; };
__device__ __forceinline__ ExTile expert_tile(int it, const float* wg, const float* wu, const float* wd, bf16_t* WGU, bf16_t* WDT) {
    const bool dn = it >= 8192; const int j = dn ? it - 8192 : it;
    const int e = dn ? j / 256 : j / 512, kind = dn ? 2 : (j % 512) / 256, t = j % 256, k0 = 64 * (t / 16), n0 = 64 * (t % 16);
    ExTile x; x.k0 = k0; x.n0 = n0;
    if (kind < 2) { x.W = (kind == 0 ? wg : wu) + (size_t)e * D * EH; x.N = EH; x.WT = WGU + (size_t)e * 2048 * D; x.Kd = D; x.drow0 = 256 * (n0 >> 7) + 128 * kind + (n0 & 127); }
    else { x.W = wd + (size_t)e * EH * D; x.N = D; x.WT = WDT + (size_t)e * D * EH; x.Kd = EH; x.drow0 = n0; }
    return x;
}
__device__ __forceinline__ void rms_regs_to_bf16(const f32x4 (&v)[4], const f32x4 (&gg)[4], bf16_t* orow, int lane) {
    float s = 0.f;
#pragma unroll
    for (int j = 0; j < 4; ++j) s += (v[j].x * v[j].x + v[j].y * v[j].y) + (v[j].z * v[j].z + v[j].w * v[j].w);
    const float r = 1.0f / sqrtf(wave_sum(s) * (1.0f / D) + EPS);
#pragma unroll
    for (int j = 0; j < 4; ++j) { const f32x4 o = v[j] * r * gg[j]; u32x2 w; w.x = cvt_pk_bf16(o[0], o[1]); w.y = cvt_pk_bf16(o[2], o[3]); *((u32x2*)orow + lane + 64 * j) = w; }
}

__device__ __forceinline__ s16x4 tr_read(const LAS unsigned char* p) {
    typedef short v4i16_t __attribute__((ext_vector_type(4)));
    return __builtin_bit_cast(s16x4, __builtin_amdgcn_ds_read_tr16_b64_v4i16((LAS v4i16_t*)p));
}

__device__ __forceinline__ float xmax(float v) { auto rr = __builtin_amdgcn_permlane32_swap(__float_as_uint(v), __float_as_uint(v), false, false); return fmaxf(__uint_as_float(rr[0]), __uint_as_float(rr[1])); }
__device__ __forceinline__ float xsum(float v) { auto rr = __builtin_amdgcn_permlane32_swap(__float_as_uint(v), __float_as_uint(v), false, false); return __uint_as_float(rr[0]) + __uint_as_float(rr[1]); }

__global__ void __launch_bounds__(NWAVES * 64, 2) mk_fwd(Args args) {
    extern __shared__ __attribute__((aligned(16))) unsigned char lds_raw[];
    LAS unsigned char* lds = (LAS unsigned char*)lds_raw;
    const int tid = threadIdx.x, lane = tid & 63, wave = __builtin_amdgcn_readfirstlane(tid >> 6);
    const int G = gridDim.x, bx = blockIdx.x;
    const int vcu = (G % 8 == 0) ? (bx % 8) * (G / 8) + bx / 8 : bx;
    const int gw = vcu * NWAVES + wave, NGW = G * NWAVES;
    unsigned char* ws = args.ws;
    float* OUT = args.out;
    const float* X = args.in[0];
    bf16_t* WSP = (bf16_t*)(ws + WS_WSP); float* GATE = (float*)(ws + WS_GATE); int* ROWTOK = (int*)(ws + WS_ROWTOK); short* SLOT = (short*)(ws + WS_SLOT); float* AFF = (float*)(ws + WS_AFF);
    bf16_t* PAT = (bf16_t*)(ws + WS_PAT); bf16_t* WOT = (bf16_t*)(ws + WS_WOT);
    bf16_t* WGU = (bf16_t*)(ws + WS_WGU); bf16_t* WDT = (bf16_t*)(ws + WS_WDT);
    bf16_t* QH = (bf16_t*)(ws + WS_QH); bf16_t* P1 = (bf16_t*)(ws + WS_P1); bf16_t* MG = (bf16_t*)(ws + WS_MG); bf16_t* YB = (bf16_t*)(ws + WS_Y); bf16_t* H2 = (bf16_t*)(ws + WS_H2); bf16_t* X1B = (bf16_t*)(ws + WS_X1);
    bf16_t* ACT = (bf16_t*)(ws + WS_ACT); bf16_t* GT = (bf16_t*)(ws + WS_GT);
    bf16_t* HB = (bf16_t*)(ws + WS_H); bf16_t* AB = (bf16_t*)(ws + WS_A);
    bf16_t* WIT = (bf16_t*)OUT;
    float* SCR = OUT;

#if MK_MODE == 2
    volatile LAS unsigned* MISC = (volatile LAS unsigned*)(lds + MISC_OFF);
    if (tid < 64) MISC[tid] = 0u;
    __syncthreads();
    XcdBarrier bar = xcd_barrier_post((unsigned*)(ws + WS_CTL) + CW_BAR, MISC + 8);
#define GRID_BAR() xcd_barrier(bar)
#elif MK_MODE == 1
#define GRID_BAR() cooperative_groups::this_grid().sync()
#else
#define GRID_BAR() do {} while (0)
#endif
#ifdef STAMP_LO
    unsigned long long ts0 = 0, ts1 = 0;
#define STAMP_AT(k) do { if ((k) == STAMP_LO) ts0 = __builtin_amdgcn_s_memrealtime(); if ((k) == STAMP_HI) ts1 = __builtin_amdgcn_s_memrealtime(); } while (0)
#else
#define STAMP_AT(k) do {} while (0)
#endif
    const int lo = args.ph_lo, hi = args.ph_hi;
#define IN(k) (lo <= (k) && (k) < hi)
#define SEAM(k) do { if (IN(k) && IN((k) + 1)) GRID_BAR(); } while (0)

    STAMP_AT(0);
    if (IN(0)) {
        LAS float* scr = (LAS float*)(lds + wave * 16640);
        constexpr int I_IN = 16 * 72, I_PA = 8 * 16, I_WO = 16 * 16, I_EX = 16 * 16;
        constexpr int NITEMS = I_IN + 2 * I_PA + I_WO;
        (void)I_EX;
        for (int it = gw; it < NITEMS; it += NGW) {
            int r = it;
            if (r < I_IN) { transpose_tile(args.in[2], INC, 64 * (r / 72), 64 * (r % 72), WIT, D, 64 * (r % 72), scr, lane); continue; } r -= I_IN;
            if (r < I_PA) { transpose_tile(args.in[7], D, 64 * (r / 16), 64 * (r % 16), PAT, D, 64 * (r % 16), scr, lane); continue; } r -= I_PA;
            if (r < I_PA) { transpose_tile(args.in[8], D, 64 * (r / 16), 64 * (r % 16), PAT + GW, D, 64 * (r % 16), scr, lane); continue; } r -= I_PA;
            transpose_tile(args.in[9], D, 64 * (r / 16), 64 * (r % 16), WOT, D, 64 * (r % 16), scr, lane);
        }
        { const float* wsrc = args.in[5];
          for (int i = (vcu * 512 + tid) * 4; i < 8 * 128 * 128; i += G * 512 * 4) { const f32x4 v = *(const f32x4*)(wsrc + i); u32x2 w; w.x = cvt_pk_bf16(v[0], v[1]); w.y = cvt_pk_bf16(v[2], v[3]); *(u32x2*)(WSP + i) = w; } }
        f32x4 gg[4];
#pragma unroll
        for (int j = 0; j < 4; ++j) gg[j] = *((const f32x4*)args.in[1] + lane + 64 * j);
        { f32x4 cur[4];
#pragma unroll
          for (int j = 0; j < 4; ++j) cur[j] = __builtin_nontemporal_load((const f32x4*)(X + (size_t)gw * D) + lane + 64 * j);
          for (int m = gw; m < T; m += NGW) { f32x4 nx[4]; const int mn = (m + NGW < T) ? m + NGW : m;
#pragma unroll
            for (int j = 0; j < 4; ++j) nx[j] = __builtin_nontemporal_load((const f32x4*)(X + (size_t)mn * D) + lane + 64 * j);
            rms_regs_to_bf16(cur, gg, HB + (size_t)m * D, lane);
#pragma unroll
            for (int j = 0; j < 4; ++j) cur[j] = nx[j]; } }
    }
    SEAM(0);

    STAMP_AT(1);
    if (IN(1)) {
        const bool full5 = (G == 256) ? (bx < 128) : true;
        const int ncv = (G == 256) ? (full5 ? 16 : 48) : (8192 + G - 1) / G, cv0 = (G == 256) ? (full5 ? bx * 16 : 128 * 16 + (bx - 128) * 48) : bx * ncv;
        const int cvsplit = (bx >> 3) & 3;
#define CONVERT_EXPERTS() do { LAS float* scr = (LAS float*)(lds + wave * 16640); const int itend = (cv0 + ncv < 8192) ? cv0 + ncv : 8192; \
            int it = cv0 + wave; TileRegs tr; ExTile xt; \
            if (it < itend) { xt = expert_tile(it, args.in[12], args.in[13], args.in[14], WGU, WDT); tile_load(tr, xt.W, xt.N, xt.k0, xt.n0, lane); } \
            while (it < itend) { const ExTile xc = xt; const TileRegs tc = tr; it += NWAVES; \
                if (it < itend) { xt = expert_tile(it, args.in[12], args.in[13], args.in[14], WGU, WDT); tile_load(tr, xt.W, xt.N, xt.k0, xt.n0, lane); } \
                tile_store(tc, xc.k0, xc.WT, xc.Kd, xc.drow0, scr, lane); } \
            __syncthreads(); } while (0)
        pg8::Gemm g{HB, WIT, T, INC, D, nullptr}; pg8::EpiProj E{P1, QH, GT, args.in[3]};
        if (cvsplit > 0) { pg8::StaticOrder S; S.init(T, INC, G, bx, -1, 0, cvsplit); pg8::gemm_phase<pg8::EpiProj>(lds, g, S, E); }
        STAMP_AT(110);
        CONVERT_EXPERTS();
        STAMP_AT(111);
        if (cvsplit < 5) { pg8::StaticOrder S; S.init(T, INC, G, bx, -1, cvsplit, 1 << 20); pg8::gemm_phase<pg8::EpiProj>(lds, g, S, E); }
#undef CONVERT_EXPERTS
    }
    STAMP_AT(114);
    SEAM(1);

    STAMP_AT(2);
    if (IN(2)) {
        for (int item = vcu; item < NB * NH * 8; item += G) {
            const int bh = item >> 3, blk = item & 7, b = bh >> 3, hd = bh & 7, Q0 = blk * 512;
            const float slope2 = __builtin_amdgcn_exp2f(-(float)(hd + 1)) * LOG2E;
            const bf16_t* qp = QH + (size_t)bh * SEQ * HD; const bf16_t* kp = qp + (size_t)T * AW; const bf16_t* vp = kp + (size_t)T * AW;
            LAS unsigned char* Kt = lds + wave * 10752; LAS unsigned char* Vt = Kt + 4608;
            const int c = lane & 31, h = lane >> 5, gi = lane & 15, g1 = (lane >> 4) & 1;
            float* scrI = SCR + (size_t)item * (512 * SCR_STRIDE);
            for (int pi = 0; pi < 3; ++pi) {
                const int dls = 4 - 2 * pi, nseq = SEQ >> dls;
                const float pen = slope2 * (float)(1 << dls);
                for (int uu = 0; uu < 2; ++uu) {
                    const int u = wave + 8 * uu, ql = 4 - dls, r = u >> ql, qt = u & ((1 << ql) - 1);
                    const int nq0 = (Q0 >> dls) + 32 * qt, tq = r + ((nq0 + c) << dls), qi = tq - Q0, nb = nq0 - 64;
                    bf16x8 qf[4];
                    { const bf16_t* qrow = qp + (size_t)tq * HD + 8 * h;
#pragma unroll
                      for (int ks = 0; ks < 4; ++ks) qf[ks] = *(const bf16x8*)(qrow + 16 * ks); }
                    f32x16 o0, o1; float m, l;
                    float* sp = scrI + (size_t)qi * SCR_STRIDE;
                    if (pi == 0) {
#pragma unroll
                        for (int i = 0; i < 16; ++i) { o0[i] = 0.f; o1[i] = 0.f; }
                        m = -1e30f; l = 0.f;
                    } else {
#pragma unroll
                        for (int rg = 0; rg < 4; ++rg) { const f32x4 a = *(const f32x4*)(sp + 8 * rg + 4 * h), bq = *(const f32x4*)(sp + 32 + 8 * rg + 4 * h);
#pragma unroll
                            for (int j = 0; j < 4; ++j) { o0[4 * rg + j] = a[j]; o1[4 * rg + j] = bq[j]; } }
                        m = sp[64]; l = sp[65];
                    }
                    float pb[16];
#pragma unroll
                    for (int i = 0; i < 16; ++i) pb[i] = pen * (float)((i & 3) + 8 * (i >> 2) + 4 * h - c);
                    const bool edge = (nb < 0) || (nb + 160 > nseq);
                    u32x4 kr[4], vr[4];
#define ATT_LOAD(kt) do { _Pragma("unroll") for (int it = 0; it < 4; ++it) { int nk = nb + 32 * (kt) + (lane >> 3) + 8 * it; nk = nk < 0 ? 0 : (nk > nseq - 1 ? nseq - 1 : nk); \
                        const size_t off = (size_t)(r + (nk << dls)) * HD + 8 * (lane & 7); kr[it] = *(const u32x4*)(kp + off); vr[it] = *(const u32x4*)(vp + off); } } while (0)
                    ATT_LOAD(0);
#pragma unroll
                    for (int kt = 0; kt < 5; ++kt) {
#pragma unroll
                        for (int it = 0; it < 4; ++it) { const int row = (lane >> 3) + 8 * it; *(LAS u32x4*)(Kt + row * 144 + 16 * (lane & 7)) = kr[it]; *(LAS u32x4*)(Vt + row * 192 + 16 * (lane & 7)) = vr[it]; }
                        if (kt < 4) ATT_LOAD(kt + 1);
                        f32x16 s;
#pragma unroll
                        for (int i = 0; i < 16; ++i) s[i] = 0.f;
#pragma unroll
                        for (int ks = 0; ks < 4; ++ks) { const bf16x8 kf = *(const LAS bf16x8*)(Kt + c * 144 + 32 * ks + 16 * h); s = __builtin_amdgcn_mfma_f32_32x32x16_bf16(kf, qf[ks], s, 0, 0, 0); }
                        const float cst = pen * (float)(32 * kt - 64);
#pragma unroll
                        for (int i = 0; i < 16; ++i) {
                            if (kt < 2) s[i] = s[i] + (pb[i] + cst); else if (kt == 2) s[i] = s[i] - __builtin_fabsf(pb[i]); else s[i] = s[i] - (pb[i] + cst);
                            if (kt == 0) s[i] = (pb[i] >= 0.f) ? s[i] : -INFINITY;
                            if (kt == 4) s[i] = (pb[i] <= 0.f) ? s[i] : -INFINITY; }
                        if (edge) {
#pragma unroll
                            for (int i = 0; i < 16; ++i) { const int nk = nb + 32 * kt + (i & 3) + 8 * (i >> 2) + 4 * h; s[i] = (nk >= 0 && nk < nseq) ? s[i] : -INFINITY; } }
                        float mx = fmaxf(fmaxf(s[0], s[1]), fmaxf(s[2], s[3]));
#pragma unroll
                        for (int i = 4; i < 16; i += 4) mx = fmaxf(mx, fmaxf(fmaxf(s[i], s[i + 1]), fmaxf(s[i + 2], s[i + 3])));
                        mx = xmax(mx);
                        const float mn = (mx > m + 8.0f) ? mx : m, alpha = __builtin_amdgcn_exp2f(m - mn);
                        float rs = 0.f;
#pragma unroll
                        for (int i = 0; i < 16; ++i) { s[i] = __builtin_amdgcn_exp2f(s[i] - mn); rs += s[i]; }
                        rs = xsum(rs);
                        l = l * alpha + rs;
                        if (__any(mn > m)) {
#pragma unroll
                            for (int i = 0; i < 16; ++i) { o0[i] *= alpha; o1[i] *= alpha; } }
                        m = mn;
                        bf16x8 pf[2];
#pragma unroll
                        for (int s2 = 0; s2 < 2; ++s2) { const unsigned w0 = cvt_pk_bf16(s[8 * s2 + 0], s[8 * s2 + 1]), w1 = cvt_pk_bf16(s[8 * s2 + 2], s[8 * s2 + 3]), w2 = cvt_pk_bf16(s[8 * s2 + 4], s[8 * s2 + 5]), w3 = cvt_pk_bf16(s[8 * s2 + 6], s[8 * s2 + 7]);
                            pf[s2] = __builtin_bit_cast(bf16x8, (u32x4){w0, w1, w2, w3}); }
#pragma unroll
                        for (int s2 = 0; s2 < 2; ++s2)
#pragma unroll
                            for (int dt = 0; dt < 2; ++dt) { const LAS unsigned char* vb = Vt + (16 * s2 + 4 * h + (gi >> 2)) * 192 + (32 * dt + 16 * g1 + 4 * (gi & 3)) * 2;
                                const s16x4 vlo = tr_read(vb), vhi = tr_read(vb + 8 * 192);
                                const bf16x8 vf = (bf16x8){vlo[0], vlo[1], vlo[2], vlo[3], vhi[0], vhi[1], vhi[2], vhi[3]};
                                if (dt == 0) o0 = __builtin_amdgcn_mfma_f32_32x32x16_bf16(vf, pf[s2], o0, 0, 0, 0); else o1 = __builtin_amdgcn_mfma_f32_32x32x16_bf16(vf, pf[s2], o1, 0, 0, 0); }
                    }
#undef ATT_LOAD
                    if (pi < 2) {
#pragma unroll
                        for (int rg = 0; rg < 4; ++rg) { *(f32x4*)(sp + 8 * rg + 4 * h) = (f32x4){o0[4 * rg], o0[4 * rg + 1], o0[4 * rg + 2], o0[4 * rg + 3]};
                            *(f32x4*)(sp + 32 + 8 * rg + 4 * h) = (f32x4){o1[4 * rg], o1[4 * rg + 1], o1[4 * rg + 2], o1[4 * rg + 3]}; }
                        if (h == 0) { sp[64] = m; sp[65] = l; }
                    } else {
                        const float inv = 1.0f / l; bf16_t* op = AB + (size_t)(b * SEQ + tq) * D + GW + 64 * hd + 4 * h;
#pragma unroll
                        for (int rg = 0; rg < 4; ++rg) { u32x2 w; w.x = cvt_pk_bf16(o0[4 * rg] * inv, o0[4 * rg + 1] * inv); w.y = cvt_pk_bf16(o0[4 * rg + 2] * inv, o0[4 * rg + 3] * inv); *(u32x2*)(op + 8 * rg) = w;
                            w.x = cvt_pk_bf16(o1[4 * rg] * inv, o1[4 * rg + 1] * inv); w.y = cvt_pk_bf16(o1[4 * rg + 2] * inv, o1[4 * rg + 3] * inv); *(u32x2*)(op + 32 + 8 * rg) = w; }
                    }
                }
                __syncthreads();
            }
        }
        STAMP_AT(102);
        for (int item = vcu; item < 256; item += G) {
            const int ch = item >> 1, hh = item & 1; const size_t t0 = (size_t)ch * 128;
            LAS float* rsq = (LAS float*)lds; LAS unsigned char* VN = lds + 512;
            __syncthreads();
            {   u32x4 raw[16];
#pragma unroll
                for (int i = 0; i < 16; ++i) raw[i] = *(const u32x4*)(P1 + (t0 + wave * 16 + i) * P1W + GW + 8 * lane);
                float ssv[16];
#pragma unroll
                for (int i = 0; i < 16; ++i) { float ss = 0.f;
#pragma unroll
                    for (int j = 0; j < 4; ++j) { const float a = bf_lo(raw[i][j]), bq = bf_hi(raw[i][j]); ss += a * a + bq * bq; }
                    ssv[i] = ss; }
#pragma unroll
                for (int o = 1; o < 64; o <<= 1) {
#pragma unroll
                    for (int i = 0; i < 16; ++i) ssv[i] += __shfl_xor(ssv[i], o); }
                float mine = 0.f;
#pragma unroll
                for (int i = 0; i < 16; ++i) mine = (lane == i) ? ssv[i] : mine;
                if (lane < 16) rsq[wave * 16 + lane] = 1.0f / sqrtf(mine * (1.0f / GW) + EPS); }
            u32x4 raw2[8];
#pragma unroll
            for (int i = 0; i < 8; ++i) { const int id = tid + 512 * i, row = id >> 5, cc = id & 31; raw2[i] = *(const u32x4*)(P1 + (t0 + row) * P1W + GW + 256 * hh + 8 * cc); }
            __syncthreads();
#pragma unroll
            for (int i = 0; i < 8; ++i) { const int id = tid + 512 * i, row = id >> 5, cc = id & 31; const u32x4 raw = raw2[i];
                const float rr = rsq[row]; const f32x4 g0 = *(const f32x4*)(args.in[4] + 256 * hh + 8 * cc), g1v = *(const f32x4*)(args.in[4] + 256 * hh + 8 * cc + 4);
                u32x4 w; w.x = cvt_pk_bf16(bf_lo(raw.x) * rr * g0[0], bf_hi(raw.x) * rr * g0[1]); w.y = cvt_pk_bf16(bf_lo(raw.y) * rr * g0[2], bf_hi(raw.y) * rr * g0[3]);
                w.z = cvt_pk_bf16(bf_lo(raw.z) * rr * g1v[0], bf_hi(raw.z) * rr * g1v[1]); w.w = cvt_pk_bf16(bf_lo(raw.w) * rr * g1v[2], bf_hi(raw.w) * rr * g1v[3]);
                *(LAS u32x4*)(VN + row * 576 + 16 * cc) = w; }
            __syncthreads();
            {
                const int gl = wave >> 1, th = wave & 1, grp = 4 * hh + gl, c = lane & 31, h = lane >> 5, gi = lane & 15, g1 = (lane >> 4) & 1;
                f32x16 acc[2][2];
#pragma unroll
                for (int a = 0; a < 2; ++a)
#pragma unroll
                    for (int bq = 0; bq < 2; ++bq)
#pragma unroll
                        for (int i = 0; i < 16; ++i) acc[a][bq][i] = 0.f;
                const bf16_t* wbase = WSP + ((size_t)grp * 128 + 64 * th + c) * 128 + 8 * h;
#pragma unroll
                for (int ks = 0; ks < 8; ++ks) {
                    bf16x8 wf[2], af[2];
#pragma unroll
                    for (int tt = 0; tt < 2; ++tt) wf[tt] = *(const bf16x8*)(wbase + (size_t)(32 * tt) * 128 + 16 * ks);
#pragma unroll
                    for (int dt = 0; dt < 2; ++dt) { const LAS unsigned char* vb = VN + (16 * ks + 8 * h + (gi >> 2)) * 576 + (64 * gl + 32 * dt + 16 * g1 + 4 * (gi & 3)) * 2;
                        const s16x4 vlo = tr_read(vb), vhi = tr_read(vb + 4 * 576);
                        af[dt] = (bf16x8){vlo[0], vlo[1], vlo[2], vlo[3], vhi[0], vhi[1], vhi[2], vhi[3]}; }
#pragma unroll
                    for (int dt = 0; dt < 2; ++dt)
#pragma unroll
                        for (int tt = 0; tt < 2; ++tt) acc[dt][tt] = __builtin_amdgcn_mfma_f32_32x32x16_bf16(af[dt], wf[tt], acc[dt][tt], 0, 0, 0);
                }
#pragma unroll
                for (int tt = 0; tt < 2; ++tt) { const int tl = 64 * th + 32 * tt + c; const size_t row = t0 + tl; const float bias = args.in[6][grp * 128 + tl];
#pragma unroll
                    for (int dt = 0; dt < 2; ++dt)
#pragma unroll
                        for (int rg = 0; rg < 4; ++rg) { const int col = 64 * grp + 32 * dt + 8 * rg + 4 * h; const u32x2 uw = *(const u32x2*)(P1 + row * P1W + col);
                            const float a0 = bf_lo(uw.x) * (acc[dt][tt][4 * rg] + bias), a1 = bf_hi(uw.x) * (acc[dt][tt][4 * rg + 1] + bias), a2 = bf_lo(uw.y) * (acc[dt][tt][4 * rg + 2] + bias), a3 = bf_hi(uw.y) * (acc[dt][tt][4 * rg + 3] + bias);
                            u32x2 w; w.x = cvt_pk_bf16(a0, a1); w.y = cvt_pk_bf16(a2, a3); *(u32x2*)(AB + row * D + col) = w; } }
            }
            __syncthreads();
        }
    }
    STAMP_AT(103);
    SEAM(2);

    STAMP_AT(3);
    if (IN(3)) {
        pg8::Gemm g{AB, PAT, T, D, D, nullptr}; pg8::StaticOrder S; S.init(T, D, G, bx, -1);
        pg8::EpiMerge E{GT, MG};
        pg8::gemm_phase<pg8::EpiMerge>(lds, g, S, E);
    }
    SEAM(3);

    STAMP_AT(4);
    if (IN(4)) {
        pg8::Gemm g{MG, WOT, T, D, D, nullptr}; pg8::StaticOrder S; S.init(T, D, G, bx, -1);
        pg8::EpiResid E{X, X1B};
        pg8::gemm_phase<pg8::EpiResid>(lds, g, S, E);
    }
    STAMP_AT(104);
    SEAM(4);
#ifdef EXTRA_BARS
    for (int xb = 0; xb < EXTRA_BARS; ++xb) GRID_BAR();
#endif

    STAMP_AT(5);
    if (IN(5)) {
        LAS float* wrt = (LAS float*)lds;
        __syncthreads();
        for (int i = tid; i < 4096; i += 512) { const int cc = i >> 2, e4 = (i & 3) * 4; const f32x4 w = *(const f32x4*)(args.in[11] + cc * 16 + e4);
            wrt[(e4 + 0) * 1024 + cc] = w[0]; wrt[(e4 + 1) * 1024 + cc] = w[1]; wrt[(e4 + 2) * 1024 + cc] = w[2]; wrt[(e4 + 3) * 1024 + cc] = w[3]; }
        __syncthreads();
        f32x4 gg[4];
#pragma unroll
        for (int j = 0; j < 4; ++j) gg[j] = *((const f32x4*)args.in[10] + lane + 64 * j);
        u32x2 nxw[4][4];
#pragma unroll
        for (int rr = 0; rr < 4; ++rr) { const int row = (gw + rr * NGW < T) ? gw + rr * NGW : gw;
#pragma unroll
            for (int j = 0; j < 4; ++j) nxw[rr][j] = *((const u32x2*)(X1B + (size_t)row * D) + lane + 64 * j); }
        for (int row0 = gw; row0 < T; row0 += 4 * NGW) {
            f32x4 v[4][4]; float ss[4];
#pragma unroll
            for (int rr = 0; rr < 4; ++rr) {
#pragma unroll
                for (int j = 0; j < 4; ++j) { const u32x2 xw = nxw[rr][j]; v[rr][j] = (f32x4){bf_lo(xw.x), bf_hi(xw.x), bf_lo(xw.y), bf_hi(xw.y)}; } }
            { const int rown0 = (row0 + 4 * NGW < T) ? row0 + 4 * NGW : row0;
#pragma unroll
              for (int rr = 0; rr < 4; ++rr) { const int row = (rown0 + rr * NGW < T) ? rown0 + rr * NGW : rown0;
#pragma unroll
                  for (int j = 0; j < 4; ++j) nxw[rr][j] = *((const u32x2*)(X1B + (size_t)row * D) + lane + 64 * j); } }
#pragma unroll
            for (int rr = 0; rr < 4; ++rr) { float a = 0.f;
#pragma unroll
                for (int j = 0; j < 4; ++j) a += (v[rr][j].x * v[rr][j].x + v[rr][j].y * v[rr][j].y) + (v[rr][j].z * v[rr][j].z + v[rr][j].w * v[rr][j].w);
                ss[rr] = a; }
#pragma unroll
            for (int o = 1; o < 64; o <<= 1) {
#pragma unroll
                for (int rr = 0; rr < 4; ++rr) ss[rr] += __shfl_xor(ss[rr], o); }
#pragma unroll
            for (int rr = 0; rr < 4; ++rr) { const int row = row0 + rr * NGW; const float r = 1.0f / sqrtf(ss[rr] * (1.0f / D) + EPS);
#pragma unroll
                for (int j = 0; j < 4; ++j) { v[rr][j] = v[rr][j] * r * gg[j];
                    if (row < T) { u32x2 w; w.x = cvt_pk_bf16(v[rr][j][0], v[rr][j][1]); w.y = cvt_pk_bf16(v[rr][j][2], v[rr][j][3]); *((u32x2*)(H2 + (size_t)row * D) + lane + 64 * j) = w; } } }
            float val[64];
#pragma unroll
            for (int e = 0; e < 16; ++e) { float a0 = 0.f, a1 = 0.f, a2 = 0.f, a3 = 0.f;
#pragma unroll
                for (int j = 0; j < 4; ++j) { const f32x4 w = *(const LAS f32x4*)(wrt + e * 1024 + 4 * lane + 256 * j);
                    a0 += (v[0][j][0] * w[0] + v[0][j][1] * w[1]) + (v[0][j][2] * w[2] + v[0][j][3] * w[3]); a1 += (v[1][j][0] * w[0] + v[1][j][1] * w[1]) + (v[1][j][2] * w[2] + v[1][j][3] * w[3]);
                    a2 += (v[2][j][0] * w[0] + v[2][j][1] * w[1]) + (v[2][j][2] * w[2] + v[2][j][3] * w[3]); a3 += (v[3][j][0] * w[0] + v[3][j][1] * w[1]) + (v[3][j][2] * w[2] + v[3][j][3] * w[3]); }
                val[e] = a0; val[16 + e] = a1; val[32 + e] = a2; val[48 + e] = a3; }
#pragma unroll
            for (int off = 32, n = 64; off >= 1; off >>= 1, n >>= 1) { const bool up = (lane & off) != 0;
#pragma unroll
                for (int k = 0; k < n / 2; ++k) { const float a = val[k], bq = val[k + n / 2]; const float send = up ? a : bq, keep = up ? bq : a; val[k] = keep + __shfl_xor(send, off); } }
            const float lg = val[0];
            float mx = lg;
#pragma unroll
            for (int o = 8; o >= 1; o >>= 1) mx = fmaxf(mx, __shfl_xor(mx, o));
            const float pe = __expf(lg - mx); float den = pe;
#pragma unroll
            for (int o = 8; o >= 1; o >>= 1) den += __shfl_xor(den, o);
            const int row = row0 + (lane >> 4) * NGW;
            if (row < T) AFF[((size_t)(row >> 12) * NE + (lane & 15)) * SEQ + (row & (SEQ - 1))] = pe / den;
        }
    }
    SEAM(5);

    STAMP_AT(6);
    if (IN(6)) {
        const int ntk = (G > 64) ? 64 : G;
        if (bx >= ntk || G <= 64) {
            LAS float* scr = (LAS float*)(lds + 1024 + wave * 16640); const int cw = (G > 64) ? bx - ntk : bx, ncw = (G > 64) ? G - ntk : G;
            int it = cw * NWAVES + wave; TileRegs tr; ExTile xt;
            if (it < 4096) { xt = expert_tile(8192 + it, args.in[12], args.in[13], args.in[14], WGU, WDT); tile_load(tr, xt.W, xt.N, xt.k0, xt.n0, lane); }
            while (it < 4096) { const ExTile xc = xt; const TileRegs tc = tr; it += ncw * NWAVES;
                if (it < 4096) { xt = expert_tile(8192 + it, args.in[12], args.in[13], args.in[14], WGU, WDT); tile_load(tr, xt.W, xt.N, xt.k0, xt.n0, lane); }
                tile_store(tc, xc.k0, xc.WT, xc.Kd, xc.drow0, scr, lane); }
        }
        for (int item = bx; item < 64 && bx < ntk; item += ntk) {
            const int be = item, b = be >> 4, e = be & 15;
            LAS int* wsum = (LAS int*)lds;
            LAS int* idxl = (LAS int*)(lds + 256);
            __syncthreads();
            unsigned v[8];
            { const float* ap = AFF + (size_t)be * SEQ + 8 * tid; const f32x4 a0 = *(const f32x4*)ap, a1 = *(const f32x4*)(ap + 4);
#pragma unroll
              for (int i = 0; i < 4; ++i) { v[i] = __float_as_uint(a0[i]); v[4 + i] = __float_as_uint(a1[i]); } }
            unsigned prefix = 0u;
            for (int bit = 30; bit >= 0; --bit) {
                const unsigned cand = prefix | (1u << bit); int cnt = 0;
#pragma unroll
                for (int i = 0; i < 8; ++i) cnt += __builtin_popcountll(__ballot(v[i] >= cand));
                if (lane == 0) wsum[(bit & 1) * 8 + wave] = cnt;
                __syncthreads();
                int tot = 0;
#pragma unroll
                for (int w = 0; w < 8; ++w) tot += wsum[(bit & 1) * 8 + w];
                if (tot >= CAP) prefix = cand;
            }
            const unsigned tau = prefix;
            int cgt = 0, ceq = 0;
#pragma unroll
            for (int i = 0; i < 8; ++i) { cgt += (v[i] > tau) ? 1 : 0; ceq += (v[i] == tau) ? 1 : 0; }
            int sce = ceq;
#pragma unroll
            for (int o = 1; o < 64; o <<= 1) { const int y = __shfl_up(sce, o); if (lane >= o) sce += y; }
            const int wgt = wave_sum_i(cgt);
            if (lane == 63) wsum[16 + wave] = sce;
            if (lane == 0) wsum[24 + wave] = wgt;
            __syncthreads();
            int ngt = 0, eqbase = sce - ceq;
#pragma unroll
            for (int w = 0; w < 8; ++w) { ngt += wsum[24 + w]; eqbase += (w < wave) ? wsum[16 + w] : 0; }
            const int need = CAP - ngt;
            unsigned selm = 0u; int nsel = 0, er = eqbase;
#pragma unroll
            for (int i = 0; i < 8; ++i) { bool sel = v[i] > tau; if (v[i] == tau) { sel = er < need; ++er; } if (sel) { selm |= (1u << i); ++nsel; } }
            int scs = nsel;
#pragma unroll
            for (int o = 1; o < 64; o <<= 1) { const int y = __shfl_up(scs, o); if (lane >= o) scs += y; }
            if (lane == 63) wsum[32 + wave] = scs;
            __syncthreads();
            int slot = scs - nsel;
#pragma unroll
            for (int w = 0; w < 8; ++w) slot += (w < wave) ? wsum[32 + w] : 0;
            unsigned spk[4];
#pragma unroll
            for (int i = 0; i < 8; ++i) { const int tok = 8 * tid + i; const bool sel = (selm >> i) & 1u;
                if (sel) { GATE[(size_t)(e * NB + b) * CAP + slot] = __uint_as_float(v[i]); ROWTOK[(size_t)(e * NB + b) * CAP + slot] = b * SEQ + tok; }
                const unsigned sv = sel ? (unsigned)slot & 0xffffu : 0xffffu; if (i & 1) spk[i >> 1] |= sv << 16; else spk[i >> 1] = sv;
                if (sel) ++slot; }
            *(u32x4*)(SLOT + (size_t)be * SEQ + 8 * tid) = (u32x4){spk[0], spk[1], spk[2], spk[3]};
            (void)idxl;
        }
    }
    STAMP_AT(106);
    SEAM(6);

    STAMP_AT(7);
    if (IN(7)) {
        pg8::Gemm g{H2, WGU, MROWS, 2 * EH, D, ROWTOK}; pg8::StaticOrder S; S.init(MROWS, 2 * EH, G, bx, 3);
        pg8::EpiSwiGLU E{ACT};
        pg8::gemm_phase<pg8::EpiSwiGLU, true, true, true>(lds, g, S, E);
    }
    SEAM(7);

    STAMP_AT(8);
    if (IN(8)) {
        pg8::Gemm g{ACT, WDT, MROWS, D, EH, nullptr}; pg8::StaticOrder S; S.init(MROWS, D, G, bx, 3);
        pg8::EpiDown E{YB, GATE};
        pg8::gemm_phase<pg8::EpiDown>(lds, g, S, E);
    }
    STAMP_AT(108);
    SEAM(8);

    STAMP_AT(9);
    if (IN(9)) {
        f32x4 gg[4];
#pragma unroll
        for (int j = 0; j < 4; ++j) gg[j] = *((const f32x4*)args.in[15] + lane + 64 * j);
        u32x2 nx9[4]; int nsl[16];
#pragma unroll
        for (int j = 0; j < 4; ++j) nx9[j] = *((const u32x2*)(X1B + (size_t)gw * D) + lane + 64 * j);
#pragma unroll
        for (int e = 0; e < 16; ++e) nsl[e] = SLOT[((size_t)(gw >> 12) * NE + e) * SEQ + (gw & (SEQ - 1))];
        for (int row = gw; row < T; row += NGW) {
            const int b = row >> 12; const int rn = (row + NGW < T) ? row + NGW : row;
            f32x4 v[4]; int sl[16];
#pragma unroll
            for (int j = 0; j < 4; ++j) v[j] = (f32x4){bf_lo(nx9[j].x), bf_hi(nx9[j].x), bf_lo(nx9[j].y), bf_hi(nx9[j].y)};
#pragma unroll
            for (int e = 0; e < 16; ++e) sl[e] = nsl[e];
#pragma unroll
            for (int j = 0; j < 4; ++j) nx9[j] = *((const u32x2*)(X1B + (size_t)rn * D) + lane + 64 * j);
#pragma unroll
            for (int e = 0; e < 16; ++e) nsl[e] = SLOT[((size_t)(rn >> 12) * NE + e) * SEQ + (rn & (SEQ - 1))];
#pragma unroll
            for (int e = 0; e < 16; ++e) { const int s1 = __builtin_amdgcn_readfirstlane(sl[e]);
                if (s1 >= 0) { const bf16_t* yp = YB + ((size_t)(e * NB + b) * CAP + s1) * D + 4 * lane;
#pragma unroll
                    for (int j = 0; j < 4; ++j) { const u32x2 yw = __builtin_nontemporal_load((const u32x2*)(yp + 256 * j)); v[j][0] += bf_lo(yw.x); v[j][1] += bf_hi(yw.x); v[j][2] += bf_lo(yw.y); v[j][3] += bf_hi(yw.y); } } }
            float s = 0.f;
#pragma unroll
            for (int j = 0; j < 4; ++j) s += (v[j].x * v[j].x + v[j].y * v[j].y) + (v[j].z * v[j].z + v[j].w * v[j].w);
            const float r = 1.0f / sqrtf(wave_sum(s) * (1.0f / D) + EPS);
#pragma unroll
            for (int j = 0; j < 4; ++j) __builtin_nontemporal_store(v[j] * r * gg[j], (f32x4*)(OUT + (size_t)row * D) + lane + 64 * j);
        }
    }
    STAMP_AT(10);
#ifdef STAMP_LO
    if (bx == STAMP_BLK && tid == 0) { const unsigned long long t0 = __builtin_amdgcn_s_memrealtime(), want = (ts1 - ts0) * STAMP_AMP; while (__builtin_amdgcn_s_memrealtime() - t0 < want) __builtin_amdgcn_s_sleep(8); }
#endif
#undef IN
#undef SEAM
}

extern "C" void kernel_launch(void* const* d_in, const int* in_sizes, int n_in, void* d_out, int out_size, void* d_ws, size_t ws_size, hipStream_t stream) {
    static int grid = 0;
    if (grid == 0) {
        if (n_in != 16 || in_sizes[0] != T * D || out_size != T * D || ws_size < WS_END) { fprintf(stderr, "kernel_launch: unexpected shapes (n_in %d, in0 %d, out %d, ws %zu < %zu)\n", n_in, n_in > 0 ? in_sizes[0] : -1, out_size, ws_size, (size_t)WS_END); grid = -1; return; }
        int dev = 0, cus = 0, per_cu = 0;
        if (hipGetDevice(&dev) != hipSuccess || hipDeviceGetAttribute(&cus, hipDeviceAttributeMultiprocessorCount, dev) != hipSuccess) { grid = -1; return; }
        if (hipFuncSetAttribute((const void*)mk_fwd, hipFuncAttributeMaxDynamicSharedMemorySize, LDS_BYTES) != hipSuccess) { fprintf(stderr, "kernel_launch: hipFuncSetAttribute failed\n"); grid = -1; return; }
        if (hipOccupancyMaxActiveBlocksPerMultiprocessor(&per_cu, (const void*)mk_fwd, NWAVES * 64, LDS_BYTES) != hipSuccess || per_cu < 1) { fprintf(stderr, "kernel_launch: occupancy query says %d blocks/CU\n", per_cu); per_cu = 1; }
        (void)hipGetLastError();
        grid = cus;
    }
    if (grid < 0) return;
    (void)hipMemsetAsync((char*)d_ws + WS_CTL, 0, 1 * MiB, stream);
    Args a{};
    for (int i = 0; i < 16; ++i) a.in[i] = (const float*)d_in[i];
    a.out = (float*)d_out; a.ws = (unsigned char*)d_ws;
#if MK_MODE == 0
    for (int p = 0; p < NPH; ++p) { a.ph_lo = p; a.ph_hi = p + 1; hipLaunchKernelGGL(mk_fwd, dim3(grid), dim3(NWAVES * 64), LDS_BYTES, stream, a); }
#elif MK_MODE == 1
    a.ph_lo = 0; a.ph_hi = NPH;
    void* kargs[] = {&a};
    hipError_t e = hipLaunchCooperativeKernel((const void*)mk_fwd, dim3(grid), dim3(NWAVES * 64), kargs, LDS_BYTES, stream);
    if (e != hipSuccess) fprintf(stderr, "kernel_launch: cooperative launch failed: %s\n", hipGetErrorString(e));
#else
    a.ph_lo = 0; a.ph_hi = NPH;
    hipLaunchKernelGGL(mk_fwd, dim3(grid), dim3(NWAVES * 64), LDS_BYTES, stream, a);
#endif
}
```

```cpp
#include <hip/hip_runtime.h>
#include <hip/hip_cooperative_groups.h>
#include <cstdio>
#include <cstdint>

#ifndef MK_MODE
#define MK_MODE 2
#endif

#ifndef STAMP_AMP
#define STAMP_AMP 4
#endif
#ifndef STAMP_BLK
#define STAMP_BLK 0
#endif
#ifndef MOE_FP8
#define MOE_FP8 1
#define P5_MFMA 1
#endif
#define LAS __attribute__((address_space(3)))
typedef unsigned short bf16_t;
typedef short bf16x8 __attribute__((ext_vector_type(8)));
typedef short s16x4 __attribute__((ext_vector_type(4)));
typedef float f32x2 __attribute__((ext_vector_type(2)));
typedef float f32x8 __attribute__((ext_vector_type(8)));
typedef float f32x4 __attribute__((ext_vector_type(4)));
typedef float f32x16 __attribute__((ext_vector_type(16)));
typedef unsigned u32x2 __attribute__((ext_vector_type(2)));
typedef unsigned u32x4 __attribute__((ext_vector_type(4)));

constexpr int NB = 4, SEQ = 4096, T = NB * SEQ, D = 1024;
constexpr int GW = 512, AW = 512, NH = 8, HD = 64;
constexpr int INC = 2 * GW + 3 * AW + 2 * D;
constexpr int P1W = 2 * GW;
constexpr int GTW = 2 * D;
constexpr int NE = 16, EH = 1024, CAP = 512;
constexpr int MROWS = NE * NB * CAP;
constexpr float EPS = 1e-6f;
constexpr float LOG2E = 1.4426950408889634f;
constexpr int NPH = 10;

constexpr size_t MiB = 1u << 20;
constexpr size_t WS_CTL = 0;
constexpr size_t WS_WSP = 1 * MiB;
constexpr size_t WS_GATE = 1 * MiB + 512 * 1024;
constexpr size_t WS_ROWTOK = 1 * MiB + 768 * 1024;
constexpr size_t WS_SLOT = 2 * MiB;
constexpr size_t WS_AFF = 3 * MiB;
constexpr size_t WS_PAT = 5 * MiB;
constexpr size_t WS_WOT = 7 * MiB;
constexpr size_t WS_WGU = 9 * MiB;
constexpr size_t WS_WDT = 73 * MiB;
constexpr size_t WS_P1 = 105 * MiB;
constexpr size_t WS_QH = 137 * MiB, WS_KH = 153 * MiB, WS_VH = 169 * MiB;
constexpr size_t WS_MG = 105 * MiB;
constexpr size_t WS_ACT = 105 * MiB;
constexpr size_t WS_Y = 169 * MiB;
constexpr size_t WS_GT = 185 * MiB;
constexpr size_t WS_H2 = 137 * MiB;
constexpr size_t WS_H = 249 * MiB;
constexpr size_t WS_A = 249 * MiB;
constexpr size_t WS_X1 = 249 * MiB;
constexpr size_t WS_END = 281 * MiB;
constexpr int SCR_STRIDE = 68;

__device__ __forceinline__ unsigned cvt_pk_bf16(float lo, float hi) { unsigned r; asm volatile("v_cvt_pk_bf16_f32 %0, %1, %2" : "=v"(r) : "v"(lo), "v"(hi)); return r; }
typedef __bf16 bf16x2_t __attribute__((ext_vector_type(2)));
__device__ __forceinline__ unsigned cvt_pk_fast(float lo, float hi) { const f32x2 v = {lo, hi}; const bf16x2_t b = __builtin_convertvector(v, bf16x2_t); return __builtin_bit_cast(unsigned, b); }
__device__ __forceinline__ unsigned cvt4_fp8(float a, float b, float c, float d) { unsigned w = 0u;
    asm("s_nop 0\n\tv_cvt_pk_fp8_f32 %0, %1, %2\n\ts_nop 1\n\tv_cvt_pk_fp8_f32 %0, %3, %4 op_sel:[0,0,1]\n\ts_nop 1" : "+v"(w) : "v"(a), "v"(b), "v"(c), "v"(d)); return w; }
constexpr float W8_SCALE = 32.0f, W8_INV = 1.0f / 32.0f;
__device__ __forceinline__ float bf_lo(unsigned w) { return __uint_as_float(w << 16); }
__device__ __forceinline__ float bf_hi(unsigned w) { return __uint_as_float(w & 0xffff0000u); }
__device__ __forceinline__ float wave_sum(float v) {
#pragma unroll
    for (int o = 1; o < 64; o <<= 1) v += __shfl_xor(v, o);
    return v;
}
__device__ __forceinline__ int wave_sum_i(int v) {
#pragma unroll
    for (int o = 1; o < 64; o <<= 1) v += __shfl_xor(v, o);
    return v;
}
__device__ __forceinline__ float fast_sigmoid(float y) { return __builtin_amdgcn_rcpf(1.0f + __builtin_amdgcn_exp2f(-LOG2E * y)); }
__device__ __forceinline__ f32x4 exp2_4(f32x4 a) { return (f32x4){__builtin_amdgcn_exp2f(a[0]), __builtin_amdgcn_exp2f(a[1]), __builtin_amdgcn_exp2f(a[2]), __builtin_amdgcn_exp2f(a[3])}; }
__device__ __forceinline__ f32x4 rcp_4(f32x4 a) { return (f32x4){__builtin_amdgcn_rcpf(a[0]), __builtin_amdgcn_rcpf(a[1]), __builtin_amdgcn_rcpf(a[2]), __builtin_amdgcn_rcpf(a[3])}; }
__device__ __forceinline__ f32x4 gelu_tanh4(f32x4 x) {
    constexpr float C1 = -2.0f * LOG2E * 0.7978845608028654f, C2 = C1 * 0.044715f;
    const f32x4 p = (x * x) * C2 + C1;
    return x * rcp_4(exp2_4(p * x) + 1.0f);
}
__device__ __forceinline__ f32x4 sigmoid4_pre(f32x4 a) { return rcp_4(exp2_4(a) + 1.0f); }
__device__ __forceinline__ f32x4 unpack_bf4(unsigned w0, unsigned w1) { return (f32x4){bf_lo(w0), bf_hi(w0), bf_lo(w1), bf_hi(w1)}; }
typedef unsigned short u16x2 __attribute__((ext_vector_type(2)));
__device__ __forceinline__ unsigned clamp_gb1(unsigned w) { const u16x2 a = __builtin_bit_cast(u16x2, w), c = {0x5D5E, 0x5D5E}; return __builtin_bit_cast(unsigned, __builtin_elementwise_min(a, c)); }
__device__ __forceinline__ u32x4 clamp_gb(u32x4 g) { return (u32x4){clamp_gb1(g[0]), clamp_gb1(g[1]), clamp_gb1(g[2]), clamp_gb1(g[3])}; }

namespace pg8 {
constexpr int BM = 256, BK = 64, HALF = 128, HTB = HALF * BK * 2, STAGE_BYTES = 8 * HTB, NXCD = 8, WGM = 8;
__host__ __device__ __forceinline__ int lds_byte(int r, int c) { const int st = (r >> 4) * 2 + (c >> 5), rr = r & 15, cc = c & 31, ob = rr * 64 + cc * 2; return st * 1024 + (ob ^ (((ob >> 9) & 1) << 5)); }
__host__ __device__ __forceinline__ void stage_rc(int b, int& R, int& C) { const int st = b / 1024, sb = b % 1024, swz = sb ^ (((sb >> 9) & 1) << 5); R = (st >> 1) * 16 + swz / 64; C = (st & 1) * 32 + (swz % 64) / 2; }
__host__ __device__ __forceinline__ int perm32(int rho) { const int n = rho >> 4, i = rho & 15; return 8 * (i >> 2) + 4 * n + (i & 3); }

struct Unit { int pm, pn; };
struct Gemm { const bf16_t* A; const bf16_t* Bt; int M, N, K; const int* rowtok; };

struct StaticOrder {
    int nM, nN, nwg, G, c, gsh, N, ibeg, iend;
    __device__ void init(int M, int N_, int G_, int c_, int gsh_, int ibeg_ = 0, int iend_ = 1 << 20) { nM = M / BM; nN = N_ / BM; nwg = nM * nN; G = G_; c = c_; gsh = gsh_; N = N_; ibeg = ibeg_; iend = iend_; }
    __device__ bool next(int i, Unit& u) const {
        if (i + ibeg >= iend) return false;
        const long L = (long)(i + ibeg) * G + c; if (L >= nwg) return false;
        int wgid = (int)L; { const int q = nwg / NXCD, r = nwg % NXCD, xcd = wgid % NXCD, off = wgid / NXCD; wgid = (xcd < r ? xcd * (q + 1) : r * (q + 1) + (xcd - r) * q) + off; }
        const int nig = WGM * nN, gid = wgid / nig, fm = gid * WGM, gsz = (nM - fm) < WGM ? (nM - fm) : WGM;
        u.pm = fm + ((wgid % nig) % gsz); u.pn = (wgid % nig) / gsz; return true;
    }
    __device__ __forceinline__ int brow(const Unit& u) const { return (gsh >= 0 ? (u.pm >> gsh) * N : 0) + u.pn * BM; }
};

typedef int v4i_t __attribute__((ext_vector_type(4)));
typedef int v8i_t __attribute__((ext_vector_type(8)));
template <class Epi, bool ALIGN_EPI = true, bool SP2 = true, bool GATHER = false, bool FP8 = false>
__device__ __forceinline__ void gemm_phase(LAS unsigned char* lds, const Gemm g, const StaticOrder& S, const Epi& E) {
    static_assert(!GATHER || SP2, "the gathered A operand is implemented for the SP2 loop");
    const int tid = threadIdx.x, wid = __builtin_amdgcn_readfirstlane(tid >> 6), lane = tid & 63, wr = wid >> 2, wc = wid & 3, fr = lane & 15, fq = lane >> 4;
    const int K = g.K, nt = K / BK;
    unsigned voffA[2], voffB[2];
#pragma unroll
    for (int i = 0; i < 2; ++i) { int R, C; stage_rc(tid * 16 + i * 8192, R, C); const int Rb = Epi::PERM ? ((R & ~31) + perm32(R & 31)) : R;
        voffA[i] = (unsigned)(R * K + C) * 2u; voffB[i] = (unsigned)(Rb * K + C) * 2u; }
    const size_t kstep = (size_t)(BK * 2);
    const size_t hstep = (size_t)HALF * K * 2;
    const size_t tstep = 2 * hstep;
    const size_t rstep = (size_t)K * 2;
    const unsigned ldsw = (unsigned)wid * 1024u;
    const int aoff = lds_byte(wr * 64 + fr, fq * 8), boff = lds_byte(wc * 32 + fr, fq * 8);
#define PG8_SA(b, h) (((b) * 2 + (h)) * HTB)
#define PG8_SB(b, h) ((4 + (b) * 2 + (h)) * HTB)
#define PG8_STAGE(bufoff, gbase, voff) do { _Pragma("unroll") for (int _i = 0; _i < 2; ++_i) \
        __builtin_amdgcn_global_load_lds((const unsigned*)((const char*)(gbase) + (voff)[_i]), (LAS unsigned*)(lds + (bufoff) + ldsw + _i * 8192), 16, 0, 0); } while (0)
#define PG8_LD8(off_) __builtin_shufflevector(*(const LAS v4i_t*)(lds + (off_)), *(const LAS v4i_t*)(lds + (off_) + 1024), 0, 1, 2, 3, 4, 5, 6, 7)
#define PG8_LDA(dst, b, h) do { _Pragma("unroll") for (int m = 0; m < 4; ++m) { if constexpr (FP8) dst##8[m] = PG8_LD8(PG8_SA(b, h) + aoff + m * 2048); \
        else { _Pragma("unroll") for (int k = 0; k < 2; ++k) dst[m][k] = *(const LAS bf16x8*)(lds + PG8_SA(b, h) + aoff + m * 2048 + k * 1024); } } } while (0)
#define PG8_LDB(dst, b, h) do { _Pragma("unroll") for (int n = 0; n < 2; ++n) { if constexpr (FP8) dst##8[n] = PG8_LD8(PG8_SB(b, h) + boff + n * 2048); \
        else { _Pragma("unroll") for (int k = 0; k < 2; ++k) dst[n][k] = *(const LAS bf16x8*)(lds + PG8_SB(b, h) + boff + n * 2048 + k * 1024); } } } while (0)
#define PG8_CAT(x) __builtin_shufflevector(__builtin_bit_cast(v4i_t, (x)[0]), __builtin_bit_cast(v4i_t, (x)[1]), 0, 1, 2, 3, 4, 5, 6, 7)
#define PG8_MMA(ai, bj, At, Bt) do { if constexpr (FP8) __builtin_amdgcn_sched_barrier(0); __builtin_amdgcn_s_setprio(1); _Pragma("unroll") for (int m = 0; m < 4; ++m) _Pragma("unroll") for (int n = 0; n < 2; ++n) { \
        if constexpr (FP8) acc[ai][bj][m][n] = __builtin_amdgcn_mfma_scale_f32_16x16x128_f8f6f4(Bt##8[n], At##8[m], acc[ai][bj][m][n], 0, 0, 0, 0x7F7F7F7F, 0, 0x7F7F7F7F); \
        else { _Pragma("unroll") for (int k = 0; k < 2; ++k) acc[ai][bj][m][n] = __builtin_amdgcn_mfma_f32_16x16x32_bf16(Bt[n][k], At[m][k], acc[ai][bj][m][n], 0, 0, 0); } } \
        if constexpr (FP8) { _Pragma("unroll") for (int m = 0; m < 4; ++m) asm volatile("" : "+v"(acc[ai][bj][m][0]), "+v"(acc[ai][bj][m][1])); }     \
        __builtin_amdgcn_s_setprio(0); if constexpr (FP8) __builtin_amdgcn_sched_barrier(0); } while (0)
#define PG8_WAIT_V(n) asm volatile("s_waitcnt vmcnt(" #n ")" ::: "memory")
#define PG8_WAIT_L(n) asm volatile("s_waitcnt lgkmcnt(" #n ")" ::: "memory")
#define PG8_BAR __builtin_amdgcn_s_barrier()
#define PG8_SCHED __builtin_amdgcn_sched_barrier(0)
    unsigned gAc[2][2], gAn[2][2];
#define PG8_GOFF(dst, u) do { if constexpr (GATHER) { _Pragma("unroll") for (int _h = 0; _h < 2; ++_h) _Pragma("unroll") for (int _i = 0; _i < 2; ++_i) { int R_, C_; stage_rc(tid * 16 + _i * 8192, R_, C_); \
        dst[_h][_i] = (unsigned)g.rowtok[(u).pm * BM + _h * HALF + R_] * (unsigned)(K * 2) + (unsigned)(C_ * 2); } } } while (0)
#define PG8_STAGEA(bufoff, SEL, H, KT) do { if constexpr (GATHER) { const char* _b = (const char*)g.A + (size_t)(KT) * kstep; \
        _Pragma("unroll") for (int _i = 0; _i < 2; ++_i) __builtin_amdgcn_global_load_lds((const unsigned*)(_b + ((SEL) ? gAn[H][_i] : gAc[H][_i])), (LAS unsigned*)(lds + (bufoff) + ldsw + _i * 8192), 16, 0, 0); } \
        else { const char* _b = ((SEL) ? nA : cA) + (size_t)(H) * hstep + (size_t)(KT) * kstep; PG8_STAGE(bufoff, _b, voffA); } } while (0)
    Unit cur, nxt; int ui = 0;
    if (!S.next(0, cur)) return;
    PG8_GOFF(gAc, cur);
    f32x4 acc[2][2][4][2];
#pragma unroll
    for (int a = 0; a < 2; ++a)
#pragma unroll
        for (int b = 0; b < 2; ++b)
#pragma unroll
            for (int m = 0; m < 4; ++m)
#pragma unroll
                for (int n = 0; n < 2; ++n) acc[a][b][m][n] = (f32x4){0.f, 0.f, 0.f, 0.f};
    bf16x8 At[4][2], B0[2][2], B1[2][2];
    v8i_t At8[4], B08[2], B18[2];
    const char* cA = (const char*)g.A + (size_t)cur.pm * tstep; const char* cB = (const char*)g.Bt + (size_t)S.brow(cur) * rstep;
    const char* nA = cA;
    if constexpr (SP2) {
        PG8_STAGE(PG8_SB(0, 0), cB, voffB); PG8_STAGE(PG8_SB(0, 1), cB + hstep, voffB); PG8_STAGEA(PG8_SA(0, 0), 0, 0, 0); PG8_STAGEA(PG8_SA(0, 1), 0, 1, 0);
        if (wr == 1) PG8_BAR;
        PG8_WAIT_V(2); PG8_BAR;
        PG8_STAGE(PG8_SB(1, 0), cB + kstep, voffB); PG8_STAGEA(PG8_SA(1, 0), 0, 0, 1); PG8_STAGE(PG8_SB(1, 1), cB + hstep + kstep, voffB);
        PG8_WAIT_V(6); PG8_BAR;
    } else {
        PG8_STAGE(PG8_SB(0, 0), cB, voffB); PG8_STAGE(PG8_SA(0, 0), cA, voffA); PG8_STAGE(PG8_SB(0, 1), cB + hstep, voffB); PG8_STAGE(PG8_SA(0, 1), cA + hstep, voffA);
        if (wr == 1) PG8_BAR;
        PG8_WAIT_V(4); PG8_BAR;
        PG8_STAGE(PG8_SB(1, 0), cB + kstep, voffB); PG8_STAGE(PG8_SA(1, 0), cA + kstep, voffA); PG8_STAGE(PG8_SB(1, 1), cB + hstep + kstep, voffB);
        PG8_WAIT_V(6); PG8_BAR;
    }
    for (;;) {
        const bool has_next = S.next(ui + 1, nxt);
        nA = has_next ? (const char*)g.A + (size_t)nxt.pm * tstep : cA; const char* nB = has_next ? (const char*)g.Bt + (size_t)S.brow(nxt) * rstep : cB;
        if constexpr (GATHER) { if (has_next) PG8_GOFF(gAn, nxt); else {
#pragma unroll
            for (int _h = 0; _h < 2; ++_h)
#pragma unroll
                for (int _i = 0; _i < 2; ++_i) gAn[_h][_i] = gAc[_h][_i]; } }
        for (int t = 0; t < nt; t += 2) {
            const bool last = (t == nt - 2);
            if constexpr (Epi::MIDK) { if (t == E.midt(nt)) E.mid(acc, cur, wr, wc, fr, fq); }
            const char* a1 = cA + (size_t)(t + 1) * kstep;
            const char* a2 = last ? nA : cA + (size_t)(t + 2) * kstep; const char* b2 = last ? nB : cB + (size_t)(t + 2) * kstep;
            const char* a3 = a2 + kstep; const char* b3 = b2 + kstep;
            if constexpr (SP2) {
            const int sel2 = last ? 1 : 0, kt2 = last ? 0 : t + 2;
            PG8_LDB(B0, 0, 0); PG8_LDB(B1, 0, 1); PG8_SCHED; PG8_LDA(At, 0, 0); PG8_STAGEA(PG8_SA(1, 1), 0, 1, t + 1);
            PG8_WAIT_V(8); PG8_WAIT_L(0); PG8_BAR; PG8_MMA(0, 0, At, B0); PG8_MMA(0, 1, At, B1); PG8_BAR; PG8_SCHED;
            PG8_LDA(At, 0, 1); PG8_STAGE(PG8_SB(0, 0), b2, voffB); PG8_STAGE(PG8_SB(0, 1), b2 + hstep, voffB); PG8_STAGEA(PG8_SA(0, 0), sel2, 0, kt2);
            PG8_WAIT_V(8); PG8_WAIT_L(0); PG8_BAR; PG8_MMA(1, 0, At, B0); PG8_MMA(1, 1, At, B1); PG8_BAR; PG8_SCHED;
            PG8_LDB(B0, 1, 0); PG8_LDB(B1, 1, 1); PG8_SCHED; PG8_LDA(At, 1, 0); PG8_STAGEA(PG8_SA(0, 1), sel2, 1, kt2);
            PG8_WAIT_V(8); PG8_WAIT_L(0); PG8_BAR; PG8_MMA(0, 0, At, B0); PG8_MMA(0, 1, At, B1); PG8_BAR; PG8_SCHED;
            PG8_LDA(At, 1, 1); PG8_STAGE(PG8_SB(1, 0), b3, voffB); PG8_STAGE(PG8_SB(1, 1), b3 + hstep, voffB); PG8_STAGEA(PG8_SA(1, 0), sel2, 0, kt2 + 1);
            PG8_WAIT_V(8); PG8_WAIT_L(0); PG8_BAR; PG8_MMA(1, 0, At, B0); PG8_MMA(1, 1, At, B1); PG8_BAR; PG8_SCHED;
            } else {
            PG8_LDB(B0, 0, 0); PG8_SCHED; PG8_LDA(At, 0, 0); PG8_STAGE(PG8_SA(1, 1), a1 + hstep, voffA);
            PG8_WAIT_L(8); PG8_BAR; PG8_WAIT_L(0); PG8_MMA(0, 0, At, B0); PG8_BAR; PG8_SCHED;
            PG8_LDB(B1, 0, 1); PG8_STAGE(PG8_SB(0, 0), b2, voffB);
            PG8_BAR; PG8_WAIT_L(0); PG8_MMA(0, 1, At, B1); PG8_BAR;
            PG8_LDA(At, 0, 1); PG8_STAGE(PG8_SA(0, 0), a2, voffA);
            PG8_BAR; PG8_WAIT_L(0); PG8_MMA(1, 0, At, B0); PG8_BAR; PG8_SCHED;
            PG8_STAGE(PG8_SB(0, 1), b2 + hstep, voffB);
            PG8_WAIT_V(6); PG8_BAR; PG8_MMA(1, 1, At, B1); PG8_BAR;
            PG8_LDB(B0, 1, 0); PG8_SCHED; PG8_LDA(At, 1, 0); PG8_STAGE(PG8_SA(0, 1), a2 + hstep, voffA);
            PG8_WAIT_L(8); PG8_BAR; PG8_WAIT_L(0); PG8_MMA(0, 0, At, B0); PG8_BAR; PG8_SCHED;
            PG8_LDB(B1, 1, 1); PG8_STAGE(PG8_SB(1, 0), b3, voffB);
            PG8_BAR; PG8_WAIT_L(0); PG8_MMA(0, 1, At, B1); PG8_BAR;
            PG8_LDA(At, 1, 1); PG8_STAGE(PG8_SA(1, 0), a3, voffA);
            PG8_BAR; PG8_WAIT_L(0); PG8_MMA(1, 0, At, B0); PG8_BAR; PG8_SCHED;
            PG8_STAGE(PG8_SB(1, 1), b3 + hstep, voffB);
            PG8_WAIT_V(6); PG8_BAR; PG8_MMA(1, 1, At, B1); PG8_BAR;
            }
        }
        if constexpr (ALIGN_EPI) { if (wr == 0) PG8_BAR; }
        E(acc, cur, wr, wc, fr, fq);
        if (!has_next) break;
#pragma unroll
        for (int a = 0; a < 2; ++a)
#pragma unroll
            for (int b = 0; b < 2; ++b)
#pragma unroll
                for (int m = 0; m < 4; ++m)
#pragma unroll
                    for (int n = 0; n < 2; ++n) acc[a][b][m][n] = (f32x4){0.f, 0.f, 0.f, 0.f};
        cur = nxt; cA = nA; cB = nB; ++ui;
        if constexpr (GATHER) {
#pragma unroll
            for (int _h = 0; _h < 2; ++_h)
#pragma unroll
                for (int _i = 0; _i < 2; ++_i) gAc[_h][_i] = gAn[_h][_i]; }
        if constexpr (ALIGN_EPI) { if (wr == 1) PG8_BAR; }
    }
    PG8_WAIT_V(0);
    if constexpr (!ALIGN_EPI) { if (wr == 0) PG8_BAR; }
    PG8_BAR;
#undef PG8_SA
#undef PG8_SB
#undef PG8_STAGE
#undef PG8_STAGEA
#undef PG8_GOFF
#undef PG8_LDA
#undef PG8_LD8
#undef PG8_LDB
#undef PG8_MMA
#undef PG8_CAT
#undef PG8_WAIT_V
#undef PG8_WAIT_L
#undef PG8_BAR
#undef PG8_SCHED
}

typedef const f32x4 (&AccRef)[2][2][4][2];
typedef f32x4 (&AccMut)[2][2][4][2];

struct EpiProj {
    static constexpr bool PERM = true, MIDK = false;
    bf16_t* UV; bf16_t* QKV; bf16_t* GT; const float* bgate;
    __device__ __forceinline__ void operator()(AccRef acc, const Unit& u, int wr, int wc, int fr, int fq) const {
        const int pn = u.pn, row0 = u.pm * BM + wr * 64 + fr, cl = wc * 32 + 8 * fq;
        const bool isg = pn >= 10, ishm = pn >= 4 && pn < 10;
        const int mode = isg ? 3 : (pn < 4 ? 1 : (pn < 6 ? 2 : 0));
        if (isg) {
            const int f0 = (pn - 10) * HALF + cl;
            f32x4 ba[2], bb[2];
#pragma unroll
            for (int n = 0; n < 2; ++n) { ba[n] = *(const f32x4*)(bgate + f0 + 4 * n) * (-LOG2E); bb[n] = *(const f32x4*)(bgate + D + f0 + 4 * n) * (-LOG2E); }
#pragma unroll
            for (int ai = 0; ai < 2; ++ai)
#pragma unroll
                for (int m = 0; m < 4; ++m) { const int row = row0 + ai * HALF + m * 16;
                    f32x4 db0 = exp2_4(acc[ai][1][m][0] * (-LOG2E) + bb[0]) + 1.0f, db1 = exp2_4(acc[ai][1][m][1] * (-LOG2E) + bb[1]) + 1.0f;
#pragma unroll
                    for (int e = 0; e < 4; ++e) { db0[e] = fminf(db0[e], 1e18f); db1[e] = fminf(db1[e], 1e18f); }
                    const f32x4 r0 = db0 * rcp_4(exp2_4(acc[ai][0][m][0] * (-LOG2E) + ba[0]) + 1.0f), r1 = db1 * rcp_4(exp2_4(acc[ai][0][m][1] * (-LOG2E) + ba[1]) + 1.0f);
                    u32x4 w; w.x = cvt_pk_bf16(r0[0], r0[1]); w.y = cvt_pk_bf16(r0[2], r0[3]); w.z = cvt_pk_bf16(r1[0], r1[1]); w.w = cvt_pk_bf16(r1[2], r1[3]);
                    *(u32x4*)(GT + (size_t)row * GTW + f0) = w;
                    w.x = cvt_pk_bf16(db0[0], db0[1]); w.y = cvt_pk_bf16(db0[2], db0[3]); w.z = cvt_pk_bf16(db1[0], db1[1]); w.w = cvt_pk_bf16(db1[2], db1[3]);
                    *(u32x4*)(GT + (size_t)row * GTW + D + f0) = w; }
            return;
        }
#pragma unroll
        for (int ai = 0; ai < 2; ++ai)
#pragma unroll
            for (int m = 0; m < 4; ++m) { const int row = row0 + ai * HALF + m * 16;
#pragma unroll
                for (int bj = 0; bj < 2; ++bj) { f32x4 v0 = acc[ai][bj][m][0], v1 = acc[ai][bj][m][1];
                    if (mode == 1) { v0 = gelu_tanh4(v0); v1 = gelu_tanh4(v1); }
                    else if (mode == 2) { v0 = v0 * (0.125f * LOG2E); v1 = v1 * (0.125f * LOG2E); }
                    u32x4 w; w.x = cvt_pk_bf16(v0[0], v0[1]); w.y = cvt_pk_bf16(v0[2], v0[3]); w.z = cvt_pk_bf16(v1[0], v1[1]); w.w = cvt_pk_bf16(v1[2], v1[3]);
                    bf16_t* dst;
                    if (ishm) { const int col = ((pn - 4) & 1) * 256 + bj * HALF + cl;
                        dst = QKV + (size_t)((pn - 4) >> 1) * ((size_t)T * AW) + ((size_t)((row >> 12) * NH + (col >> 6)) * SEQ + (row & (SEQ - 1))) * HD + (col & 63); }
                    else dst = UV + (size_t)row * P1W + pn * 256 + bj * HALF + cl;
                    *(u32x4*)dst = w; } }
    }
};
struct EpiMerge {
    static constexpr bool PERM = true, MIDK = true;
    const bf16_t* GT; bf16_t* MG;
    __device__ __forceinline__ int midt(int nt) const { return nt / 2; }
    __device__ __forceinline__ void mid(AccMut acc, const Unit& u, int wr, int wc, int fr, int fq) const {
        asm volatile("" : "+v"(fr), "+v"(fq));
        const int row0 = u.pm * BM + wr * 64 + fr, col0 = u.pn * BM + wc * 32 + 8 * fq;
        u32x4 rt[2][4][2];
#pragma unroll
        for (int ai = 0; ai < 2; ++ai)
#pragma unroll
            for (int m = 0; m < 4; ++m)
#pragma unroll
                for (int bj = 0; bj < 2; ++bj) rt[ai][m][bj] = *(const u32x4*)(GT + (size_t)(row0 + ai * HALF + m * 16) * GTW + col0 + bj * HALF);
#pragma unroll
        for (int ai = 0; ai < 2; ++ai)
#pragma unroll
            for (int m = 0; m < 4; ++m)
#pragma unroll
                for (int bj = 0; bj < 2; ++bj) { const u32x4 q4 = rt[ai][m][bj];
                    acc[ai][bj][m][0] = acc[ai][bj][m][0] * unpack_bf4(q4[0], q4[1]); acc[ai][bj][m][1] = acc[ai][bj][m][1] * unpack_bf4(q4[2], q4[3]); }
    }
    __device__ __forceinline__ void operator()(AccRef acc, const Unit& u, int wr, int wc, int fr, int fq) const {
        const int row0 = u.pm * BM + wr * 64 + fr, col0 = u.pn * BM + wc * 32 + 8 * fq;
#pragma unroll
        for (int ai = 0; ai < 2; ++ai)
#pragma unroll
            for (int m = 0; m < 4; ++m) { const size_t r = (size_t)(row0 + ai * HALF + m * 16);
#pragma unroll
                for (int bj = 0; bj < 2; ++bj) { const u32x4 gb = *(const u32x4*)(GT + r * GTW + D + col0 + bj * HALF);
                    const f32x4 v0 = acc[ai][bj][m][0] * rcp_4(unpack_bf4(gb[0], gb[1])), v1 = acc[ai][bj][m][1] * rcp_4(unpack_bf4(gb[2], gb[3]));
                    u32x4 w; w.x = cvt_pk_bf16(v0[0], v0[1]); w.y = cvt_pk_bf16(v0[2], v0[3]); w.z = cvt_pk_bf16(v1[0], v1[1]); w.w = cvt_pk_bf16(v1[2], v1[3]);
                    *(u32x4*)(MG + r * D + col0 + bj * HALF) = w; } }
    }
};
struct EpiResid {
    static constexpr bool PERM = true, MIDK = false;
    const float* X; bf16_t* X1;
    __device__ __forceinline__ void operator()(AccRef acc, const Unit& u, int wr, int wc, int fr, int fq) const {
        const int row0 = u.pm * BM + wr * 64 + fr, col0 = u.pn * BM + wc * 32 + 8 * fq;
#pragma unroll
        for (int ai = 0; ai < 2; ++ai)
#pragma unroll
            for (int m = 0; m < 4; ++m) { const size_t r = (size_t)(row0 + ai * HALF + m * 16);
#pragma unroll
                for (int bj = 0; bj < 2; ++bj) { const int c = col0 + bj * HALF;
                    const f32x4 o0 = *(const f32x4*)(X + r * D + c) + acc[ai][bj][m][0], o1 = *(const f32x4*)(X + r * D + c + 4) + acc[ai][bj][m][1];
                    u32x4 w; w.x = cvt_pk_bf16(o0[0], o0[1]); w.y = cvt_pk_bf16(o0[2], o0[3]); w.z = cvt_pk_bf16(o1[0], o1[1]); w.w = cvt_pk_bf16(o1[2], o1[3]);
                    *(u32x4*)(X1 + r * D + c) = w; } }
    }
};
struct EpiSwiGLU {
    static constexpr bool PERM = true, MIDK = false;
    bf16_t* ACT;
    __device__ __forceinline__ void operator()(AccRef acc, const Unit& u, int wr, int wc, int fr, int fq) const {
        const int row0 = u.pm * BM + wr * 64 + fr, col0 = u.pn * HALF + wc * 32 + 8 * fq;
#pragma unroll
        for (int ai = 0; ai < 2; ++ai)
#pragma unroll
            for (int m = 0; m < 4; ++m) {
                f32x4 o[2];
#pragma unroll
                for (int n = 0; n < 2; ++n) {
                    constexpr float WI = MOE_FP8 ? W8_INV : 1.0f;
                    const f32x4 ag = acc[ai][0][m][n], au = acc[ai][1][m][n];
                    o[n] = (ag * sigmoid4_pre(ag * (-LOG2E * WI))) * (au * (WI * WI)); }
#if MOE_FP8
                unsigned char* rowp = (unsigned char*)ACT + (size_t)(row0 + ai * HALF + m * 16) * EH + col0;
                u32x2 w; w.x = cvt4_fp8(o[0][0], o[0][1], o[0][2], o[0][3]); w.y = cvt4_fp8(o[1][0], o[1][1], o[1][2], o[1][3]);
                *(u32x2*)rowp = w;
#else
                bf16_t* rowp = ACT + (size_t)(row0 + ai * HALF + m * 16) * EH + col0;
                u32x4 w; w.x = cvt_pk_bf16(o[0][0], o[0][1]); w.y = cvt_pk_bf16(o[0][2], o[0][3]); w.z = cvt_pk_bf16(o[1][0], o[1][1]); w.w = cvt_pk_bf16(o[1][2], o[1][3]);
                *(u32x4*)rowp = w;
#endif
            }
    }
};
struct EpiDown {
    static constexpr bool PERM = true, MIDK = false;
    bf16_t* Y; const float* gate;
    __device__ __forceinline__ void operator()(AccRef acc, const Unit& u, int wr, int wc, int fr, int fq) const {
        const int row0 = u.pm * BM + wr * 64 + fr, col0 = u.pn * BM + wc * 32 + 8 * fq;
#pragma unroll
        for (int ai = 0; ai < 2; ++ai)
#pragma unroll
            for (int m = 0; m < 4; ++m) { const int r = row0 + ai * HALF + m * 16; const float gt = gate[r] * (MOE_FP8 ? W8_INV : 1.0f); bf16_t* rowp = Y + (size_t)r * D + col0;
#pragma unroll
                for (int bj = 0; bj < 2; ++bj) { const f32x4 v0 = acc[ai][bj][m][0] * gt, v1 = acc[ai][bj][m][1] * gt;
                    u32x4 w; w.x = cvt_pk_bf16(v0[0], v0[1]); w.y = cvt_pk_bf16(v0[2], v0[3]); w.z = cvt_pk_bf16(v1[0], v1[1]); w.w = cvt_pk_bf16(v1[2], v1[3]);
                    *(u32x4*)(rowp + bj * HALF) = w; } }
    }
};
}

#define XB_EARLY_INV 1
#define XB_FLAT_RELEASE 1
#define XB_TMO      128
#define XB_XCNT(j)  (256  + 64 * (j))
#define XB_XSUB(j)  (1280 + 64 * (j))
#define XB_XGEN(j)  (2304 + 64 * (j))
#define XB_TOP      3328
#define XB_TOPGEN   3392
#define XCD_BAR_WORDS 3456
#define XB_SPIN_CAP (1u << 18)
__device__ __forceinline__ unsigned xb_ld(unsigned* p)              { return __hip_atomic_load(p, __ATOMIC_RELAXED, __HIP_MEMORY_SCOPE_AGENT); }
__device__ __forceinline__ unsigned xb_add(unsigned* p, unsigned v) { return __hip_atomic_fetch_add(p, v, __ATOMIC_RELAXED, __HIP_MEMORY_SCOPE_AGENT); }
__device__ __forceinline__ unsigned xb_xcc_id() { return (unsigned)__builtin_amdgcn_s_getreg((3 << 11) | 20) & 0xFu; }
#define XB_SPIN(cond, bar) do { unsigned _sp = 0; while (cond) { __builtin_amdgcn_s_sleep(1); \
    if ((++_sp & 255u) == 0u) { if (xb_ld(&(bar)[XB_TMO])) break; if (_sp > XB_SPIN_CAP) { atomicAdd(&(bar)[XB_TMO], 1u); break; } } } } while (0)
struct XcdBarrier { unsigned* bar; unsigned x; volatile LAS unsigned* st; };
__device__ __forceinline__ XcdBarrier xcd_barrier_post(unsigned* bar, volatile LAS unsigned* st) {
    XcdBarrier b; b.bar = bar; b.x = xb_xcc_id(); b.st = st;
    if (threadIdx.x == 0) (void)xb_add(&bar[XB_XCNT(b.x)], 1u);
    return b;
}
__device__ __forceinline__ void xcd_barrier_complete(unsigned* bar, unsigned x, unsigned& nloc, unsigned& nx) {
    const unsigned G = gridDim.x * gridDim.y * gridDim.z;
    unsigned sum, cnt, mine, sp = 0u;
    for (;;) {
        sum = 0u; cnt = 0u; mine = 0u;
#pragma unroll
        for (unsigned j = 0; j < 16; ++j) { const unsigned c = xb_ld(&bar[XB_XCNT(j)]); sum += c; cnt += (c > 0u) ? 1u : 0u; mine = (j == x) ? c : mine; }
        if (sum == G) break;
        __builtin_amdgcn_s_sleep(1);
        if ((++sp & 255u) == 0u) { if (xb_ld(&bar[XB_TMO])) break; if (sp > XB_SPIN_CAP) { atomicAdd(&bar[XB_TMO], 1u); break; } }
    }
    nloc = mine > 0u ? mine : 1u; nx = cnt > 0u ? cnt : 1u;
}
__device__ __forceinline__ void xcd_barrier(const XcdBarrier& b) {
    asm volatile("s_waitcnt vmcnt(0)" ::: "memory");
    __syncthreads();
    if (threadIdx.x == 0) {
        unsigned* bar = b.bar;
        __builtin_amdgcn_s_waitcnt(0);
#if XB_EARLY_INV
        asm volatile("buffer_inv sc1" ::: "memory");
#endif
        unsigned nloc = b.st[0], nx = b.st[1];
        if (nloc == 0u) { xcd_barrier_complete(bar, b.x, nloc, nx); b.st[0] = nloc; b.st[1] = nx; }
        const unsigned old = xb_add(&bar[XB_XSUB(b.x)], 1u);
        const unsigned gen = old / nloc;
        if (old + 1u == (gen + 1u) * nloc) {
            __builtin_amdgcn_fence(__ATOMIC_RELEASE, "agent");
            asm volatile("s_waitcnt vmcnt(0)" ::: "memory");
            const unsigned og = xb_add(&bar[XB_TOP], 1u);
            const unsigned tg = og / nx;
            if (og + 1u == (tg + 1u) * nx) xb_add(&bar[XB_TOPGEN], 1u);
            else XB_SPIN(xb_ld(&bar[XB_TOPGEN]) == tg, bar);
#if !XB_EARLY_INV
            __builtin_amdgcn_fence(__ATOMIC_ACQUIRE, "agent");
#endif
#if !XB_FLAT_RELEASE
            xb_add(&bar[XB_XGEN(b.x)], 1u);
#endif
            asm volatile("s_waitcnt vmcnt(0)" ::: "memory");
        } else {
#if XB_FLAT_RELEASE
            XB_SPIN(xb_ld(&bar[XB_TOPGEN]) == gen, bar);
#else
            XB_SPIN(xb_ld(&bar[XB_XGEN(b.x)]) == gen, bar);
#endif
#if !XB_EARLY_INV
            __builtin_amdgcn_fence(__ATOMIC_ACQUIRE, "agent");
#endif
            asm volatile("s_waitcnt vmcnt(0)" ::: "memory");
        }
    }
    __syncthreads();
}

__device__ __forceinline__ void xcd_barrier_arrive(const XcdBarrier& b) {
    asm volatile("s_waitcnt vmcnt(0)" ::: "memory");
    __syncthreads();
    if (threadIdx.x == 0) {
        unsigned* bar = b.bar;
        __builtin_amdgcn_s_waitcnt(0);
        asm volatile("buffer_inv sc1" ::: "memory");
        unsigned nloc = b.st[0], nx = b.st[1];
        if (nloc == 0u) { xcd_barrier_complete(bar, b.x, nloc, nx); b.st[0] = nloc; b.st[1] = nx; }
        const unsigned old = xb_add(&bar[XB_XSUB(b.x)], 1u);
        const unsigned gen = old / nloc;
        if (old + 1u == (gen + 1u) * nloc) {
            __builtin_amdgcn_fence(__ATOMIC_RELEASE, "agent");
            asm volatile("s_waitcnt vmcnt(0)" ::: "memory");
            const unsigned og = xb_add(&bar[XB_TOP], 1u);
            const unsigned tg = og / nx;
            if (og + 1u == (tg + 1u) * nx) xb_add(&bar[XB_TOPGEN], 1u);
        }
        b.st[2] = gen;
    }
}
__device__ __forceinline__ void xcd_barrier_wait(const XcdBarrier& b) {
    if (threadIdx.x == 0) {
        unsigned* bar = b.bar;
        const unsigned gen = b.st[2];
        XB_SPIN(xb_ld(&bar[XB_TOPGEN]) == gen, bar);
        asm volatile("s_waitcnt vmcnt(0)" ::: "memory");
    }
    __syncthreads();
}

template <bool INV = true>
__device__ __forceinline__ void group_arrive4(unsigned* w32) {
    asm volatile("s_waitcnt vmcnt(0)" ::: "memory");
    __syncthreads();
    if (threadIdx.x == 0) {
        if (INV) asm volatile("buffer_inv sc1" ::: "memory");
        (void)__hip_atomic_fetch_add((unsigned long long*)w32, 1ull + (1ull << (8u + 3u * xb_xcc_id())), __ATOMIC_RELAXED, __HIP_MEMORY_SCOPE_AGENT);
    }
}
__device__ __forceinline__ void group_wait4(unsigned* w32, unsigned* tmo_bar) {
    if (threadIdx.x == 0) {
        unsigned long long* w = (unsigned long long*)w32;
        const unsigned x = xb_xcc_id();
        unsigned long long v = 0ull;
        XB_SPIN(((v = __hip_atomic_load(w, __ATOMIC_RELAXED, __HIP_MEMORY_SCOPE_AGENT)) & 0xffull) < 4ull, tmo_bar);
        if (((unsigned)(v >> (8u + 3u * x)) & 7u) != 4u) {
            __builtin_amdgcn_fence(__ATOMIC_RELEASE, "agent");
            asm volatile("s_waitcnt vmcnt(0)" ::: "memory");
            (void)xb_add(w32 + 8, 1u);
            XB_SPIN(xb_ld(w32 + 8) < 4u, tmo_bar);
            __builtin_amdgcn_fence(__ATOMIC_ACQUIRE, "agent");
        }
        asm volatile("s_waitcnt vmcnt(0)" ::: "memory");
    }
    __syncthreads();
}
__device__ __forceinline__ void group_rendezvous4(unsigned* w32, unsigned* tmo_bar) { group_arrive4<false>(w32); group_wait4(w32, tmo_bar); }

constexpr int NWAVES = 8;
constexpr int LDS_BYTES = 147456;
constexpr int MISC_OFF = 144 * 1024 - 256;
constexpr int CW_BAR = 4096;
constexpr int CW_RDV = 16384;

struct Args { const float* in[16]; float* out; unsigned char* ws; int ph_lo, ph_hi; };

struct TileRegs { f32x4 v[16]; };
__device__ __forceinline__ void tile_load(TileRegs& t, const float* W, int N, int k0, int n0, int lane) {
    const int n4 = (lane & 15) * 4, kq = lane >> 4;
#pragma unroll
    for (int i = 0; i < 16; ++i) t.v[i] = __builtin_nontemporal_load((const f32x4*)(W + (size_t)(k0 + 4 * i + kq) * N + n0 + n4));
}
__device__ __forceinline__ void tile_store(const TileRegs& t, int k0, bf16_t* WT, int Kd, int drow0, LAS float* scr, int lane) {
    const int n4 = (lane & 15) * 4, kq = lane >> 4;
#pragma unroll
    for (int i = 0; i < 16; ++i) { LAS float* s = scr + (4 * i + kq) * 65 + n4; s[0] = t.v[i][0]; s[1] = t.v[i][1]; s[2] = t.v[i][2]; s[3] = t.v[i][3]; }
    asm volatile("s_waitcnt lgkmcnt(0)" ::: "memory");
    const int c = lane & 7;
#pragma unroll
    for (int jj = 0; jj < 8; ++jj) { const int n = (lane >> 3) + 8 * jj; const LAS float* s = scr + (8 * c) * 65 + n;
        u32x4 o; o.x = cvt_pk_fast(s[0], s[65]); o.y = cvt_pk_fast(s[2 * 65], s[3 * 65]); o.z = cvt_pk_fast(s[4 * 65], s[5 * 65]); o.w = cvt_pk_fast(s[6 * 65], s[7 * 65]);
        __builtin_nontemporal_store(o, (u32x4*)(WT + (size_t)(drow0 + n) * Kd + k0 + 8 * c)); }
    asm volatile("s_waitcnt lgkmcnt(0)" ::: "memory");
}
__device__ __forceinline__ void transpose_tile(const float* W, int N, int k0, int n0, bf16_t* WT, int Kd, int drow0, LAS float* scr, int lane) {
    TileRegs t; tile_load(t, W, N, k0, n0, lane); tile_store(t, k0, WT, Kd, drow0, scr, lane);
}
struct ExTile { const float* W; int N, k0, n0; bf16_t* WT; int Kd, drow0; };
__device__ __forceinline__ ExTile expert_tile(int it, const float* wg, const float* wu, const float* wd, bf16_t* WGU, bf16_t* WDT) {
    const bool dn = it >= 8192; const int j = dn ? it - 8192 : it;
    const int e = dn ? j / 256 : j / 512, kind = dn ? 2 : (j % 512) / 256, t = j % 256, k0 = 64 * (t / 16), n0 = 64 * (t % 16);
    ExTile x; x.k0 = k0; x.n0 = n0;
    if (kind < 2) { x.W = (kind == 0 ? wg : wu) + (size_t)e * D * EH; x.N = EH; x.WT = WGU + (size_t)e * 2048 * D; x.Kd = D; x.drow0 = 256 * (n0 >> 7) + 128 * kind + (n0 & 127); }
    else { x.W = wd + (size_t)e * EH * D; x.N = D; x.WT = WDT + (size_t)e * D * EH; x.Kd = EH; x.drow0 = n0; }
    return x;
}
__device__ __forceinline__ void tile8_convert(const float* W, int N, int k0, int n0, unsigned char* WT8, int Kd, int drow0, LAS unsigned char* scr, int lane) {
    const int q = lane & 15, g = lane >> 4;
    TileRegs ta, tb;
#pragma unroll
    for (int i = 0; i < 16; ++i) ta.v[i] = __builtin_nontemporal_load((const f32x4*)((const char*)W + (unsigned)(((k0 + 16 * g + i) * N + n0 + 4 * q) * 4)));
#pragma unroll
    for (int i = 0; i < 16; ++i) tb.v[i] = __builtin_nontemporal_load((const f32x4*)((const char*)W + (unsigned)(((k0 + 64 + 16 * g + i) * N + n0 + 4 * q) * 4)));
#pragma unroll
    for (int j = 0; j < 4; ++j) { u32x4 o;
        o.x = cvt4_fp8(ta.v[0][j] * W8_SCALE, ta.v[1][j] * W8_SCALE, ta.v[2][j] * W8_SCALE, ta.v[3][j] * W8_SCALE); o.y = cvt4_fp8(ta.v[4][j] * W8_SCALE, ta.v[5][j] * W8_SCALE, ta.v[6][j] * W8_SCALE, ta.v[7][j] * W8_SCALE);
        o.z = cvt4_fp8(ta.v[8][j] * W8_SCALE, ta.v[9][j] * W8_SCALE, ta.v[10][j] * W8_SCALE, ta.v[11][j] * W8_SCALE); o.w = cvt4_fp8(ta.v[12][j] * W8_SCALE, ta.v[13][j] * W8_SCALE, ta.v[14][j] * W8_SCALE, ta.v[15][j] * W8_SCALE);
        *(LAS u32x4*)(scr + (4 * q + j) * 144 + 16 * g) = o; }
#pragma unroll
    for (int j = 0; j < 4; ++j) { u32x4 o;
        o.x = cvt4_fp8(tb.v[0][j] * W8_SCALE, tb.v[1][j] * W8_SCALE, tb.v[2][j] * W8_SCALE, tb.v[3][j] * W8_SCALE); o.y = cvt4_fp8(tb.v[4][j] * W8_SCALE, tb.v[5][j] * W8_SCALE, tb.v[6][j] * W8_SCALE, tb.v[7][j] * W8_SCALE);
        o.z = cvt4_fp8(tb.v[8][j] * W8_SCALE, tb.v[9][j] * W8_SCALE, tb.v[10][j] * W8_SCALE, tb.v[11][j] * W8_SCALE); o.w = cvt4_fp8(tb.v[12][j] * W8_SCALE, tb.v[13][j] * W8_SCALE, tb.v[14][j] * W8_SCALE, tb.v[15][j] * W8_SCALE);
        *(LAS u32x4*)(scr + (4 * q + j) * 144 + 64 + 16 * g) = o; }
    asm volatile("s_waitcnt lgkmcnt(0)" ::: "memory");
    const int c = lane & 7;
#pragma unroll
    for (int jj = 0; jj < 8; ++jj) { const int n = (lane >> 3) + 8 * jj; const u32x4 o = *(const LAS u32x4*)(scr + n * 144 + 16 * c);
        __builtin_nontemporal_store(o, (u32x4*)(WT8 + (unsigned)((drow0 + n) * Kd + k0 + 16 * c))); }
    asm volatile("s_waitcnt lgkmcnt(0)" ::: "memory");
}
__device__ __forceinline__ void expert_tile8(int it, const float* wg, const float* wu, const float* wd, unsigned char* WGU8, unsigned char* WDT8, LAS unsigned char* scr, int lane) {
    const bool dn = it >= 4096; const int j = dn ? it - 4096 : it;
    const int e = dn ? j / 128 : j / 256, kind = dn ? 2 : (j % 256) / 128, t = j % 128, k0 = 128 * (t / 16), n0 = 64 * (t % 16);
    if (kind < 2) tile8_convert((kind == 0 ? wg : wu) + (size_t)e * D * EH, EH, k0, n0, WGU8 + (size_t)e * 2048 * D, D, 256 * (n0 >> 7) + 128 * kind + (n0 & 127), scr, lane);
    else tile8_convert(wd + (size_t)e * EH * D, D, k0, n0, WDT8 + (size_t)e * D * EH, EH, n0, scr, lane);
}
struct Tile8 { const float* W; int N, k0, n0; unsigned char* WT8; int Kd, drow0; };
__device__ __forceinline__ Tile8 expert_tile8_desc(int it, const float* wg, const float* wu, const float* wd, unsigned char* WGU8, unsigned char* WDT8) {
    const bool dn = it >= 4096; const int j = dn ? it - 4096 : it;
    const int e = dn ? j / 128 : j / 256, kind = dn ? 2 : (j % 256) / 128, t = j % 128, k0 = 128 * (t / 16), n0 = 64 * (t % 16);
    Tile8 x; x.k0 = k0; x.n0 = n0;
    if (kind < 2) { x.W = (kind == 0 ? wg : wu) + (size_t)e * D * EH; x.N = EH; x.WT8 = WGU8 + (size_t)e * 2048 * D; x.Kd = D; x.drow0 = 256 * (n0 >> 7) + 128 * kind + (n0 & 127); }
    else { x.W = wd + (size_t)e * EH * D; x.N = D; x.WT8 = WDT8 + (size_t)e * D * EH; x.Kd = EH; x.drow0 = n0; }
    return x;
}
__device__ __forceinline__ void tile8_load_half(TileRegs& t, const Tile8& x, int half, int lane) {
    const int q = lane & 15, g = lane >> 4;
#pragma unroll
    for (int i = 0; i < 16; ++i) t.v[i] = __builtin_nontemporal_load((const f32x4*)((const char*)x.W + (unsigned)(((x.k0 + 64 * half + 16 * g + i) * x.N + x.n0 + 4 * q) * 4)));
}
__device__ __forceinline__ void tile8_cvt_half(const TileRegs& t, int half, LAS unsigned char* scr, int lane) {
    const int q = lane & 15, g = lane >> 4;
    f32x4 sv[16];
#pragma unroll
    for (int i = 0; i < 16; ++i) sv[i] = t.v[i] * W8_SCALE;
#pragma unroll
    for (int j = 0; j < 4; ++j) { u32x4 o;
        o.x = cvt4_fp8(sv[0][j], sv[1][j], sv[2][j], sv[3][j]); o.y = cvt4_fp8(sv[4][j], sv[5][j], sv[6][j], sv[7][j]);
        o.z = cvt4_fp8(sv[8][j], sv[9][j], sv[10][j], sv[11][j]); o.w = cvt4_fp8(sv[12][j], sv[13][j], sv[14][j], sv[15][j]);
        *(LAS u32x4*)(scr + (4 * q + j) * 144 + 64 * half + 16 * g) = o; }
}
__device__ __forceinline__ void tile8_store(const Tile8& x, LAS unsigned char* scr, int lane) {
    asm volatile("s_waitcnt lgkmcnt(0)" ::: "memory");
    const int c = lane & 7;
#pragma unroll
    for (int jj = 0; jj < 8; ++jj) { const int n = (lane >> 3) + 8 * jj; const u32x4 o = *(const LAS u32x4*)(scr + n * 144 + 16 * c);
        __builtin_nontemporal_store(o, (u32x4*)(x.WT8 + (unsigned)((x.drow0 + n) * x.Kd + x.k0 + 16 * c))); }
    asm volatile("s_waitcnt lgkmcnt(0)" ::: "memory");
}
__device__ __forceinline__ void expert_tiles8_pipelined(int first, int step, int end, int dnoff, const float* wg, const float* wu, const float* wd, unsigned char* WGU8, unsigned char* WDT8,
                                                        LAS unsigned char* scr, int lane) {
    if (first >= end) return;
    __builtin_amdgcn_s_waitcnt(0x0F70);
    TileRegs ta, tb;
    Tile8 xc = expert_tile8_desc(first < 4096 ? first : first + dnoff, wg, wu, wd, WGU8, WDT8);
    tile8_load_half(ta, xc, 0, lane); tile8_load_half(tb, xc, 1, lane);
    for (int itn = first + step; itn < end; itn += step) {
        const Tile8 xn = expert_tile8_desc(itn < 4096 ? itn : itn + dnoff, wg, wu, wd, WGU8, WDT8);
        tile8_cvt_half(ta, 0, scr, lane);
        __builtin_amdgcn_sched_barrier(0);
        tile8_load_half(ta, xn, 0, lane);
        __builtin_amdgcn_sched_barrier(0);
        tile8_cvt_half(tb, 1, scr, lane);
        __builtin_amdgcn_sched_barrier(0);
        tile8_load_half(tb, xn, 1, lane);
        __builtin_amdgcn_sched_barrier(0);
        tile8_store(xc, scr, lane);
        xc = xn;
    }
    tile8_cvt_half(ta, 0, scr, lane); tile8_cvt_half(tb, 1, scr, lane); tile8_store(xc, scr, lane);
}
__device__ __forceinline__ void rms_regs_to_bf16(const f32x4 (&v)[4], const f32x4 (&gg)[4], bf16_t* orow, int lane) {
    float s = 0.f;
#pragma unroll
    for (int j = 0; j < 4; ++j) s += (v[j].x * v[j].x + v[j].y * v[j].y) + (v[j].z * v[j].z + v[j].w * v[j].w);
    const float r = 1.0f / sqrtf(wave_sum(s) * (1.0f / D) + EPS);
#pragma unroll
    for (int j = 0; j < 4; ++j) { const f32x4 o = v[j] * r * gg[j]; u32x2 w; w.x = cvt_pk_bf16(o[0], o[1]); w.y = cvt_pk_bf16(o[2], o[3]); *((u32x2*)orow + lane + 64 * j) = w; }
}

__device__ __forceinline__ s16x4 tr_read(const LAS unsigned char* p) {
    typedef short v4i16_t __attribute__((ext_vector_type(4)));
    return __builtin_bit_cast(s16x4, __builtin_amdgcn_ds_read_tr16_b64_v4i16((LAS v4i16_t*)p));
}

__device__ __forceinline__ void att_load(u32x4 (&R)[4], const bf16_t* p, int dls, int r, int nb, int kt, int lane) {
    const int nseq = SEQ >> dls;
#pragma unroll
    for (int it = 0; it < 4; ++it) { int nk = nb + 32 * kt + (lane >> 3) + 8 * it; nk = nk < 0 ? 0 : (nk > nseq - 1 ? nseq - 1 : nk);
        const unsigned off = (unsigned)(r + (nk << dls)) * (unsigned)(HD * 2) + 16u * (unsigned)(lane & 7);
        R[it] = *(const u32x4*)((const char*)p + off); }
}
__device__ __forceinline__ void att_stage(const u32x4 (&R)[4], LAS unsigned char* Tl, int pitch, int lane) {
#pragma unroll
    for (int it = 0; it < 4; ++it) { const int row = (lane >> 3) + 8 * it; *(LAS u32x4*)(Tl + row * pitch + 16 * (lane & 7)) = R[it]; }
}
__device__ __forceinline__ void att_loadq(bf16x8 (&qf)[4], const bf16_t* qp, int tq, int h) {
    const unsigned off = (unsigned)tq * (unsigned)(HD * 2) + 16u * (unsigned)h;
#pragma unroll
    for (int ks = 0; ks < 4; ++ks) qf[ks] = *(const bf16x8*)((const char*)qp + off + 32 * ks);
}
__device__ __forceinline__ f32x16 att_scores(const LAS unsigned char* Kt, const bf16x8 (&qf)[4], int lane, f32x16 s) {
    const int c = lane & 31, h = lane >> 5;
#pragma unroll
    for (int ks = 0; ks < 4; ++ks) { const bf16x8 kf = *(const LAS bf16x8*)(Kt + c * 144 + 32 * ks + 16 * h); s = __builtin_amdgcn_mfma_f32_32x32x16_bf16(kf, qf[ks], s, 0, 0, 0); }
    return s;
}
template <int KT>
__device__ __forceinline__ f32x16 att_bias_init(const f32x16& pb, float pen) {
    const float cst = pen * (float)(32 * KT - 64);
    if (KT < 2) return pb + cst;
    if (KT > 2) return -(pb + cst);
    f32x16 r;
#pragma unroll
    for (int i = 0; i < 16; ++i) r[i] = -__builtin_fabsf(pb[i]);
    return r;
}
template <int KT>
__device__ __forceinline__ float att_bias(f32x16& s, const f32x16& pb, float pen, int nb, int nseq, bool edge, int h) {
#pragma unroll
    for (int i = 0; i < 16; ++i) {
        if (KT == 0) s[i] = (pb[i] >= 0.f) ? s[i] : -INFINITY;
        if (KT == 4) s[i] = (pb[i] <= 0.f) ? s[i] : -INFINITY; }
    if (edge) {
#pragma unroll
        for (int i = 0; i < 16; ++i) { const int nk = nb + 32 * KT + (i & 3) + 8 * (i >> 2) + 4 * h; s[i] = (nk >= 0 && nk < nseq) ? s[i] : -INFINITY; } }
    float mx = fmaxf(fmaxf(s[0], s[1]), fmaxf(s[2], s[3]));
#pragma unroll
    for (int i = 4; i < 16; i += 4) mx = fmaxf(mx, fmaxf(fmaxf(s[i], s[i + 1]), fmaxf(s[i + 2], s[i + 3])));
    return mx;
}
__device__ __forceinline__ float att_probs(const f32x16& s, float m, bf16x8 (&pf)[2]) {
    const f32x16 d = s - m; f32x16 p;
#pragma unroll
    for (int i = 0; i < 16; ++i) p[i] = __builtin_amdgcn_exp2f(d[i]);
    const f32x8 r8 = __builtin_shufflevector(p, p, 0, 1, 2, 3, 4, 5, 6, 7) + __builtin_shufflevector(p, p, 8, 9, 10, 11, 12, 13, 14, 15);
    const f32x4 r4 = __builtin_shufflevector(r8, r8, 0, 1, 2, 3) + __builtin_shufflevector(r8, r8, 4, 5, 6, 7);
    const float rs = (r4[0] + r4[1]) + (r4[2] + r4[3]);
#pragma unroll
    for (int s2 = 0; s2 < 2; ++s2) { const unsigned w0 = cvt_pk_fast(p[8 * s2 + 0], p[8 * s2 + 1]), w1 = cvt_pk_fast(p[8 * s2 + 2], p[8 * s2 + 3]), w2 = cvt_pk_fast(p[8 * s2 + 4], p[8 * s2 + 5]), w3 = cvt_pk_fast(p[8 * s2 + 6], p[8 * s2 + 7]);
        pf[s2] = __builtin_bit_cast(bf16x8, (u32x4){w0, w1, w2, w3}); }
    return rs;
}
__device__ __forceinline__ void att_pv(f32x16& o0, f32x16& o1, const LAS unsigned char* Vt, const bf16x8 (&pf)[2], int lane) {
    const int h = lane >> 5, gi = lane & 15, g1 = (lane >> 4) & 1;
#pragma unroll
    for (int s2 = 0; s2 < 2; ++s2)
#pragma unroll
        for (int dt = 0; dt < 2; ++dt) { const LAS unsigned char* vb = Vt + (16 * s2 + 4 * h + (gi >> 2)) * 192 + (32 * dt + 16 * g1 + 4 * (gi & 3)) * 2;
            const s16x4 vlo = tr_read(vb), vhi = tr_read(vb + 8 * 192);
            const bf16x8 vf = (bf16x8){vlo[0], vlo[1], vlo[2], vlo[3], vhi[0], vhi[1], vhi[2], vhi[3]};
            if (dt == 0) o0 = __builtin_amdgcn_mfma_f32_32x32x16_bf16(vf, pf[s2], o0, 0, 0, 0); else o1 = __builtin_amdgcn_mfma_f32_32x32x16_bf16(vf, pf[s2], o1, 0, 0, 0); }
}
__device__ __forceinline__ float xmax(float v) { auto rr = __builtin_amdgcn_permlane32_swap(__float_as_uint(v), __float_as_uint(v), false, false); return fmaxf(__uint_as_float(rr[0]), __uint_as_float(rr[1])); }
__device__ __forceinline__ float xsum(float v) { auto rr = __builtin_amdgcn_permlane32_swap(__float_as_uint(v), __float_as_uint(v), false, false); return __uint_as_float(rr[0]) + __uint_as_float(rr[1]); }

__global__ void __launch_bounds__(NWAVES * 64, 2) mk_fwd(Args args) {
    extern __shared__ __attribute__((aligned(16))) unsigned char lds_raw[];
    LAS unsigned char* lds = (LAS unsigned char*)lds_raw;
    const int tid = threadIdx.x, lane = tid & 63, wave = __builtin_amdgcn_readfirstlane(tid >> 6);
    const int G = gridDim.x, bx = blockIdx.x;
    const int vcu = (G % 8 == 0) ? (bx % 8) * (G / 8) + bx / 8 : bx;
    const int gw = vcu * NWAVES + wave, NGW = G * NWAVES;
    unsigned char* ws = args.ws;
    float* OUT = args.out;
    const float* X = args.in[0];
    bf16_t* WSP = (bf16_t*)(ws + WS_WSP); float* GATE = (float*)(ws + WS_GATE); int* ROWTOK = (int*)(ws + WS_ROWTOK); short* SLOT = (short*)(ws + WS_SLOT); float* AFF = (float*)(ws + WS_AFF);
    bf16_t* PAT = (bf16_t*)(ws + WS_PAT); bf16_t* WOT = (bf16_t*)(ws + WS_WOT);
    bf16_t* WGU = (bf16_t*)(ws + WS_WGU); bf16_t* WDT = (bf16_t*)(ws + WS_WDT);
    bf16_t* QH = (bf16_t*)(ws + WS_QH); bf16_t* P1 = (bf16_t*)(ws + WS_P1); bf16_t* MG = (bf16_t*)(ws + WS_MG); bf16_t* YB = (bf16_t*)(ws + WS_Y); bf16_t* H2 = (bf16_t*)(ws + WS_H2); bf16_t* X1B = (bf16_t*)(ws + WS_X1);
    bf16_t* ACT = (bf16_t*)(ws + WS_ACT); bf16_t* GT = (bf16_t*)(ws + WS_GT);
    bf16_t* HB = (bf16_t*)(ws + WS_H); bf16_t* AB = (bf16_t*)(ws + WS_A);
    bf16_t* WIT = (bf16_t*)OUT;
    float* SCR = OUT;

#if MK_MODE == 2
    volatile LAS unsigned* MISC = (volatile LAS unsigned*)(lds + MISC_OFF);
    if (tid < 64) MISC[tid] = 0u;
    __syncthreads();
    XcdBarrier bar = xcd_barrier_post((unsigned*)(ws + WS_CTL) + CW_BAR, MISC + 8);
#define GRID_BAR() xcd_barrier(bar)
#elif MK_MODE == 1
#define GRID_BAR() cooperative_groups::this_grid().sync()
#else
#define GRID_BAR() do {} while (0)
#endif
#ifdef STAMP_LO
    unsigned long long ts0 = 0, ts1 = 0;
#define STAMP_AT(k) do { if ((k) == STAMP_LO) ts0 = __builtin_amdgcn_s_memrealtime(); if ((k) == STAMP_HI) ts1 = __builtin_amdgcn_s_memrealtime(); } while (0)
#else
#define STAMP_AT(k) do {} while (0)
#endif
    const int lo = args.ph_lo, hi = args.ph_hi;
#define IN(k) (lo <= (k) && (k) < hi)
#define SEAM(k) do { if (IN(k) && IN((k) + 1)) GRID_BAR(); } while (0)
#if MK_MODE == 2
#define SEAM_GROUP(k, slot) do { if (IN(k) && IN((k) + 1)) { if (G == 256) group_rendezvous4((unsigned*)(ws + WS_CTL) + CW_RDV + (slot) * 4096 + 32 * (((bx & 7) << 3) | ((bx >> 3) & 7)), (unsigned*)(ws + WS_CTL) + CW_BAR); else GRID_BAR(); } } while (0)
#else
#define SEAM_GROUP(k, slot) SEAM(k)
#endif
#define GROUP_WORD(slot) ((unsigned*)(ws + WS_CTL) + CW_RDV + (slot) * 4096 + 32 * (((bx & 7) << 3) | ((bx >> 3) & 7)))
#if MK_MODE == 2 && XB_FLAT_RELEASE
#define SEAM_GROUP_ARRIVE(k, slot) do { if (IN(k) && IN((k) + 1)) { if (G == 256) group_arrive4(GROUP_WORD(slot)); else xcd_barrier_arrive(bar); } } while (0)
#define SEAM_GROUP_WAIT(k, slot) do { if (IN(k) && IN((k) + 1)) { if (G == 256) group_wait4(GROUP_WORD(slot), (unsigned*)(ws + WS_CTL) + CW_BAR); else xcd_barrier_wait(bar); } } while (0)
#else
#define SEAM_GROUP_ARRIVE(k, slot) do {} while (0)
#define SEAM_GROUP_WAIT(k, slot) SEAM(k)
#endif
#if MK_MODE == 2 && XB_FLAT_RELEASE
#define SEAM_ARRIVE(k) do { if (IN(k) && IN((k) + 1)) xcd_barrier_arrive(bar); } while (0)
#define SEAM_WAIT(k) do { if (IN(k) && IN((k) + 1)) xcd_barrier_wait(bar); } while (0)
#else
#define SEAM_ARRIVE(k) do {} while (0)
#define SEAM_WAIT(k) SEAM(k)
#endif

    STAMP_AT(0);
    if (IN(0)) {
        LAS float* scr = (LAS float*)(lds + wave * 16640);
        constexpr int I_IN = 16 * 72, I_PA = 8 * 16, I_WO = 16 * 16, I_EX = 16 * 16;
        constexpr int NITEMS = I_IN + 2 * I_PA + I_WO;
        (void)I_EX;
        for (int it = gw; it < NITEMS; it += NGW) {
            int r = it;
            if (r < I_IN) { const int n0 = 64 * (r % 72); int dr = n0;
                if (n0 >= 2560) { const int cg = n0 - 2560, hh = cg >> 10, f0 = cg & 1023; dr = 2560 + 256 * (f0 >> 7) + 128 * hh + (f0 & 127); }
                transpose_tile(args.in[2], INC, 64 * (r / 72), n0, WIT, D, dr, scr, lane); continue; } r -= I_IN;
            if (r < I_PA) { transpose_tile(args.in[7], D, 64 * (r / 16), 64 * (r % 16), PAT, D, 64 * (r % 16), scr, lane); continue; } r -= I_PA;
            if (r < I_PA) { transpose_tile(args.in[8], D, 64 * (r / 16), 64 * (r % 16), PAT + GW, D, 64 * (r % 16), scr, lane); continue; } r -= I_PA;
            transpose_tile(args.in[9], D, 64 * (r / 16), 64 * (r % 16), WOT, D, 64 * (r % 16), scr, lane);
        }
        { const float* wsrc = args.in[5];
          for (int i = (vcu * 512 + tid) * 4; i < 8 * 128 * 128; i += G * 512 * 4) { const f32x4 v = *(const f32x4*)(wsrc + i); u32x2 w; w.x = cvt_pk_bf16(v[0], v[1]); w.y = cvt_pk_bf16(v[2], v[3]); *(u32x2*)(WSP + i) = w; } }
        f32x4 gg[4];
#pragma unroll
        for (int j = 0; j < 4; ++j) gg[j] = *((const f32x4*)args.in[1] + lane + 64 * j);
        { f32x4 cur[4];
#pragma unroll
          for (int j = 0; j < 4; ++j) cur[j] = __builtin_nontemporal_load((const f32x4*)(X + (size_t)gw * D) + lane + 64 * j);
          for (int m = gw; m < T; m += NGW) { f32x4 nx[4]; const int mn = (m + NGW < T) ? m + NGW : m;
#pragma unroll
            for (int j = 0; j < 4; ++j) nx[j] = __builtin_nontemporal_load((const f32x4*)(X + (size_t)mn * D) + lane + 64 * j);
            rms_regs_to_bf16(cur, gg, HB + (size_t)m * D, lane);
#pragma unroll
            for (int j = 0; j < 4; ++j) cur[j] = nx[j]; } }
    }
    SEAM_ARRIVE(0);

    STAMP_AT(1);
    if (IN(1)) {
#if MOE_FP8
        const bool full5 = (G == 256) ? (bx < 128) : true;
        constexpr int P1_DN = 512, P1_NT = 4096 + P1_DN;
        const int ncv = (G == 256) ? (full5 ? 8 : 28) : (P1_NT + G - 1) / G, cv0 = (G == 256) ? (full5 ? bx * 8 : 128 * 8 + (bx - 128) * 28) : bx * ncv;
        const int cvsplit = (G == 256 && full5) ? 0 : (bx >> 3) & 3;
#define CONVERT_EXPERTS() do { LAS unsigned char* scr8 = lds + wave * 16640; const int itend = (cv0 + ncv < P1_NT) ? cv0 + ncv : P1_NT; \
            expert_tiles8_pipelined(cv0 + wave, NWAVES, itend, 2048 - P1_DN, args.in[12], args.in[13], args.in[14], (unsigned char*)WGU, (unsigned char*)WDT, scr8, lane); \
            __syncthreads(); } while (0)
#else
        const bool full5 = (G == 256) ? (bx < 128) : true;
        const int ncv = (G == 256) ? (full5 ? 16 : 48) : (8192 + G - 1) / G, cv0 = (G == 256) ? (full5 ? bx * 16 : 128 * 16 + (bx - 128) * 48) : bx * ncv;
        const int cvsplit = (bx >> 3) & 3;
#define CONVERT_EXPERTS() do { LAS float* scr = (LAS float*)(lds + wave * 16640); const int itend = (cv0 + ncv < 8192) ? cv0 + ncv : 8192; \
            int it = cv0 + wave; TileRegs tr; ExTile xt; \
            if (it < itend) { xt = expert_tile(it, args.in[12], args.in[13], args.in[14], WGU, WDT); tile_load(tr, xt.W, xt.N, xt.k0, xt.n0, lane); } \
            while (it < itend) { const ExTile xc = xt; const TileRegs tc = tr; it += NWAVES; \
                if (it < itend) { xt = expert_tile(it, args.in[12], args.in[13], args.in[14], WGU, WDT); tile_load(tr, xt.W, xt.N, xt.k0, xt.n0, lane); } \
                tile_store(tc, xc.k0, xc.WT, xc.Kd, xc.drow0, scr, lane); } \
            __syncthreads(); } while (0)
#endif
        pg8::Gemm g{HB, WIT, T, INC, D, nullptr}; pg8::EpiProj E{P1, QH, GT, args.in[3]};
        if (cvsplit > 0) { SEAM_WAIT(0); pg8::StaticOrder S; S.init(T, INC, G, bx, -1, 0, cvsplit); pg8::gemm_phase<pg8::EpiProj>(lds, g, S, E); }
        STAMP_AT(110);
        CONVERT_EXPERTS();
        STAMP_AT(111);
        if (cvsplit == 0) SEAM_WAIT(0);
        if (cvsplit < 5) { pg8::StaticOrder S; S.init(T, INC, G, bx, -1, cvsplit, 1 << 20); pg8::gemm_phase<pg8::EpiProj>(lds, g, S, E); }
#undef CONVERT_EXPERTS
    }
    STAMP_AT(114);
    SEAM(1);

    STAMP_AT(2);
    if (IN(2)) {
        for (int item = vcu; item < NB * NH * 8; item += G) {
            const int bh = item >> 3, blk = item & 7, b = bh >> 3, hd = bh & 7, Q0 = blk * 512;
            const float slope2 = __builtin_amdgcn_exp2f(-(float)(hd + 1)) * LOG2E;
            const bf16_t* qp = QH + (size_t)bh * SEQ * HD; const bf16_t* kp = qp + (size_t)T * AW; const bf16_t* vp = kp + (size_t)T * AW;
            LAS unsigned char* Kt = lds + wave * 10752; LAS unsigned char* Vt = Kt + 4608;
            const int c = lane & 31, h = lane >> 5;
            float* scrI = SCR + (size_t)item * (512 * SCR_STRIDE);
#define UNIT_CTX(pi_, uu_, dls_, r_, nb_, tq_) const int dls_ = 4 - 2 * (pi_); int r_, nb_, tq_; { const int u_ = wave + 8 * (uu_), ql_ = 4 - dls_; r_ = u_ >> ql_; const int qt_ = u_ & ((1 << ql_) - 1); \
                const int nq0_ = (Q0 >> dls_) + 32 * qt_; nb_ = nq0_ - 64; tq_ = r_ + ((nq0_ + c) << dls_); }
            u32x4 XA[4], XB[4]; bf16x8 qf[4];
            { UNIT_CTX(0, 0, d0, r0, nb0, tq0); att_loadq(qf, qp, tq0, h); att_load(XA, kp, d0, r0, nb0, 0, lane); att_load(XB, kp, d0, r0, nb0, 1, lane); }
#pragma unroll 1
            for (int st = 0; st < 6; ++st) {
                const int pi = st >> 1, uu = st & 1;
                UNIT_CTX(pi, uu, dls, rC, nbC, tqC);
                const int stn = st < 5 ? st + 1 : 5; UNIT_CTX(stn >> 1, stn & 1, dlsN, rN, nbN, tqN);
                const bool more = st < 5;
                const int nseq = SEQ >> dls; const float pen = slope2 * (float)(1 << dls);
                const bool edge = (nbC < 0) || (nbC + 160 > nseq);
                f32x16 pb;
#pragma unroll
                for (int i = 0; i < 16; ++i) pb[i] = pen * (float)((i & 3) + 8 * (i >> 2) + 4 * h - c);
                f32x16 s0, s1, s2, s3, s4;
                att_stage(XA, Kt, 144, lane); att_load(XA, kp, dls, rC, nbC, 2, lane); s0 = att_scores(Kt, qf, lane, att_bias_init<0>(pb, pen));
                att_stage(XB, Kt, 144, lane); att_load(XB, kp, dls, rC, nbC, 3, lane); s1 = att_scores(Kt, qf, lane, att_bias_init<1>(pb, pen));
                att_stage(XA, Kt, 144, lane); att_load(XA, kp, dls, rC, nbC, 4, lane); s2 = att_scores(Kt, qf, lane, att_bias_init<2>(pb, pen));
                att_stage(XB, Kt, 144, lane); att_load(XB, vp, dls, rC, nbC, 0, lane); s3 = att_scores(Kt, qf, lane, att_bias_init<3>(pb, pen));
                att_stage(XA, Kt, 144, lane); att_load(XA, vp, dls, rC, nbC, 1, lane); s4 = att_scores(Kt, qf, lane, att_bias_init<4>(pb, pen));
                if (more) att_loadq(qf, qp, tqN, h);
                float mx = att_bias<0>(s0, pb, pen, nbC, nseq, edge, h);
                mx = fmaxf(mx, att_bias<1>(s1, pb, pen, nbC, nseq, edge, h));
                mx = fmaxf(mx, att_bias<2>(s2, pb, pen, nbC, nseq, edge, h));
                mx = fmaxf(mx, att_bias<3>(s3, pb, pen, nbC, nseq, edge, h));
                mx = fmaxf(mx, att_bias<4>(s4, pb, pen, nbC, nseq, edge, h));
                const float mu = xmax(mx);
                bf16x8 pf0[2], pf1[2], pf2[2], pf3[2], pf4[2];
                float lu = att_probs(s0, mu, pf0); lu += att_probs(s1, mu, pf1); lu += att_probs(s2, mu, pf2); lu += att_probs(s3, mu, pf3); lu += att_probs(s4, mu, pf4);
                lu = xsum(lu);
                f32x16 o0, o1;
#pragma unroll
                for (int i = 0; i < 16; ++i) { o0[i] = 0.f; o1[i] = 0.f; }
                att_stage(XB, Vt, 192, lane); att_load(XB, vp, dls, rC, nbC, 2, lane); att_pv(o0, o1, Vt, pf0, lane);
                att_stage(XA, Vt, 192, lane); att_load(XA, vp, dls, rC, nbC, 3, lane); att_pv(o0, o1, Vt, pf1, lane);
                att_stage(XB, Vt, 192, lane); att_load(XB, vp, dls, rC, nbC, 4, lane); att_pv(o0, o1, Vt, pf2, lane);
                float* sp = (float*)((char*)scrI + (unsigned)(tqC - Q0) * (unsigned)(SCR_STRIDE * 4));
                f32x4 so0[4], so1[4]; float ms = -1e30f, ls = 0.f;
                if (pi > 0) {
#pragma unroll
                    for (int rg = 0; rg < 4; ++rg) { so0[rg] = *(const f32x4*)(sp + 8 * rg + 4 * h); so1[rg] = *(const f32x4*)(sp + 32 + 8 * rg + 4 * h); }
                    ms = sp[64]; ls = sp[65];
                } else {
#pragma unroll
                    for (int rg = 0; rg < 4; ++rg) { so0[rg] = (f32x4){0.f, 0.f, 0.f, 0.f}; so1[rg] = (f32x4){0.f, 0.f, 0.f, 0.f}; }
                }
                att_stage(XA, Vt, 192, lane); if (more) att_load(XA, kp, dlsN, rN, nbN, 0, lane); att_pv(o0, o1, Vt, pf3, lane);
                att_stage(XB, Vt, 192, lane); if (more) att_load(XB, kp, dlsN, rN, nbN, 1, lane); att_pv(o0, o1, Vt, pf4, lane);
                const float M = fmaxf(ms, mu), as = __builtin_amdgcn_exp2f(ms - M), au = __builtin_amdgcn_exp2f(mu - M);
                const float lt = ls * as + lu * au;
                if (pi < 2) {
#pragma unroll
                    for (int rg = 0; rg < 4; ++rg) {
                        *(f32x4*)(sp + 8 * rg + 4 * h) = (f32x4){so0[rg][0] * as + o0[4 * rg] * au, so0[rg][1] * as + o0[4 * rg + 1] * au, so0[rg][2] * as + o0[4 * rg + 2] * au, so0[rg][3] * as + o0[4 * rg + 3] * au};
                        *(f32x4*)(sp + 32 + 8 * rg + 4 * h) = (f32x4){so1[rg][0] * as + o1[4 * rg] * au, so1[rg][1] * as + o1[4 * rg + 1] * au, so1[rg][2] * as + o1[4 * rg + 2] * au, so1[rg][3] * as + o1[4 * rg + 3] * au}; }
                    if (h == 0) { sp[64] = M; sp[65] = lt; }
                } else {
                    const float inv = 1.0f / lt, ws_ = as * inv, wu_ = au * inv;
                    bf16_t* op = (bf16_t*)((char*)AB + ((unsigned)(b * SEQ + tqC) * (unsigned)D + (unsigned)(GW + 64 * hd + 4 * h)) * 2u);
#pragma unroll
                    for (int rg = 0; rg < 4; ++rg) { u32x2 w;
                        w.x = cvt_pk_fast(so0[rg][0] * ws_ + o0[4 * rg] * wu_, so0[rg][1] * ws_ + o0[4 * rg + 1] * wu_); w.y = cvt_pk_fast(so0[rg][2] * ws_ + o0[4 * rg + 2] * wu_, so0[rg][3] * ws_ + o0[4 * rg + 3] * wu_); *(u32x2*)(op + 8 * rg) = w;
                        w.x = cvt_pk_fast(so1[rg][0] * ws_ + o1[4 * rg] * wu_, so1[rg][1] * ws_ + o1[4 * rg + 1] * wu_); w.y = cvt_pk_fast(so1[rg][2] * ws_ + o1[4 * rg + 2] * wu_, so1[rg][3] * ws_ + o1[4 * rg + 3] * wu_); *(u32x2*)(op + 32 + 8 * rg) = w; }
                }
                if (uu == 1) __syncthreads();
            }
#undef UNIT_CTX
        }
        STAMP_AT(102);
        for (int item = vcu; item < 256; item += G) {
            const int ch = item >> 1, hh = item & 1; const size_t t0 = (size_t)ch * 128;
            LAS float* rsq = (LAS float*)lds; LAS unsigned char* VN = lds + 512;
            __syncthreads();
            {   u32x4 raw[16];
#pragma unroll
                for (int i = 0; i < 16; ++i) raw[i] = *(const u32x4*)(P1 + (t0 + wave * 16 + i) * P1W + GW + 8 * lane);
                float ssv[16];
#pragma unroll
                for (int i = 0; i < 16; ++i) { float ss = 0.f;
#pragma unroll
                    for (int j = 0; j < 4; ++j) { const float a = bf_lo(raw[i][j]), bq = bf_hi(raw[i][j]); ss += a * a + bq * bq; }
                    ssv[i] = ss; }
#pragma unroll
                for (int o = 1; o < 64; o <<= 1) {
#pragma unroll
                    for (int i = 0; i < 16; ++i) ssv[i] += __shfl_xor(ssv[i], o); }
                float mine = 0.f;
#pragma unroll
                for (int i = 0; i < 16; ++i) mine = (lane == i) ? ssv[i] : mine;
                if (lane < 16) rsq[wave * 16 + lane] = 1.0f / sqrtf(mine * (1.0f / GW) + EPS); }
            u32x4 raw2[8];
#pragma unroll
            for (int i = 0; i < 8; ++i) { const int id = tid + 512 * i, row = id >> 5, cc = id & 31; raw2[i] = *(const u32x4*)(P1 + (t0 + row) * P1W + GW + 256 * hh + 8 * cc); }
            const int gl_ = wave >> 1, th_ = wave & 1, grp_ = 4 * hh + gl_;
            bf16x8 wfp[8][2]; u32x2 uwp[2][2][4]; float biasp[2];
            { const bf16_t* wbase = WSP + ((size_t)grp_ * 128 + 64 * th_ + (lane & 31)) * 128 + 8 * (lane >> 5);
#pragma unroll
              for (int ks = 0; ks < 8; ++ks)
#pragma unroll
                  for (int tt = 0; tt < 2; ++tt) wfp[ks][tt] = *(const bf16x8*)(wbase + (size_t)(32 * tt) * 128 + 16 * ks);
#pragma unroll
              for (int tt = 0; tt < 2; ++tt) { const int tl = 64 * th_ + 32 * tt + (lane & 31); const size_t row = t0 + tl; biasp[tt] = args.in[6][grp_ * 128 + tl];
#pragma unroll
                  for (int dt = 0; dt < 2; ++dt)
#pragma unroll
                      for (int rg = 0; rg < 4; ++rg) uwp[tt][dt][rg] = *(const u32x2*)(P1 + row * P1W + 64 * grp_ + 32 * dt + 8 * rg + 4 * (lane >> 5)); } }
            __syncthreads();
#pragma unroll
            for (int i = 0; i < 8; ++i) { const int id = tid + 512 * i, row = id >> 5, cc = id & 31; const u32x4 raw = raw2[i];
                const float rr = rsq[row]; const f32x4 g0 = *(const f32x4*)(args.in[4] + 256 * hh + 8 * cc), g1v = *(const f32x4*)(args.in[4] + 256 * hh + 8 * cc + 4);
                u32x4 w; w.x = cvt_pk_bf16(bf_lo(raw.x) * rr * g0[0], bf_hi(raw.x) * rr * g0[1]); w.y = cvt_pk_bf16(bf_lo(raw.y) * rr * g0[2], bf_hi(raw.y) * rr * g0[3]);
                w.z = cvt_pk_bf16(bf_lo(raw.z) * rr * g1v[0], bf_hi(raw.z) * rr * g1v[1]); w.w = cvt_pk_bf16(bf_lo(raw.w) * rr * g1v[2], bf_hi(raw.w) * rr * g1v[3]);
                *(LAS u32x4*)(VN + row * 576 + 16 * cc) = w; }
            __syncthreads();
            {
                const int gl = wave >> 1, th = wave & 1, grp = 4 * hh + gl, c = lane & 31, h = lane >> 5, gi = lane & 15, g1 = (lane >> 4) & 1;
                f32x16 acc[2][2];
#pragma unroll
                for (int a = 0; a < 2; ++a)
#pragma unroll
                    for (int bq = 0; bq < 2; ++bq)
#pragma unroll
                        for (int i = 0; i < 16; ++i) acc[a][bq][i] = 0.f;
#pragma unroll
                for (int ks = 0; ks < 8; ++ks) {
                    bf16x8 wf[2], af[2];
#pragma unroll
                    for (int tt = 0; tt < 2; ++tt) wf[tt] = wfp[ks][tt];
#pragma unroll
                    for (int dt = 0; dt < 2; ++dt) { const LAS unsigned char* vb = VN + (16 * ks + 8 * h + (gi >> 2)) * 576 + (64 * gl + 32 * dt + 16 * g1 + 4 * (gi & 3)) * 2;
                        const s16x4 vlo = tr_read(vb), vhi = tr_read(vb + 4 * 576);
                        af[dt] = (bf16x8){vlo[0], vlo[1], vlo[2], vlo[3], vhi[0], vhi[1], vhi[2], vhi[3]}; }
#pragma unroll
                    for (int dt = 0; dt < 2; ++dt)
#pragma unroll
                        for (int tt = 0; tt < 2; ++tt) acc[dt][tt] = __builtin_amdgcn_mfma_f32_32x32x16_bf16(af[dt], wf[tt], acc[dt][tt], 0, 0, 0);
                }
#pragma unroll
                for (int tt = 0; tt < 2; ++tt) { const int tl = 64 * th + 32 * tt + c; const size_t row = t0 + tl; const float bias = biasp[tt];
#pragma unroll
                    for (int dt = 0; dt < 2; ++dt)
#pragma unroll
                        for (int rg = 0; rg < 4; ++rg) { const int col = 64 * grp + 32 * dt + 8 * rg + 4 * h; const u32x2 uw = uwp[tt][dt][rg];
                            const float a0 = bf_lo(uw.x) * (acc[dt][tt][4 * rg] + bias), a1 = bf_hi(uw.x) * (acc[dt][tt][4 * rg + 1] + bias), a2 = bf_lo(uw.y) * (acc[dt][tt][4 * rg + 2] + bias), a3 = bf_hi(uw.y) * (acc[dt][tt][4 * rg + 3] + bias);
                            u32x2 w; w.x = cvt_pk_bf16(a0, a1); w.y = cvt_pk_bf16(a2, a3); *(u32x2*)(AB + row * D + col) = w; } }
            }
            __syncthreads();
        }
    }
    STAMP_AT(103);
    SEAM(2);

    STAMP_AT(3);
    if (IN(3)) {
        pg8::Gemm g{AB, PAT, T, D, D, nullptr}; pg8::StaticOrder S; S.init(T, D, G, bx, -1);
        pg8::EpiMerge E{GT, MG};
        pg8::gemm_phase<pg8::EpiMerge>(lds, g, S, E);
    }
    SEAM_GROUP(3, 0);

    STAMP_AT(4);
    if (IN(4)) {
        pg8::Gemm g{MG, WOT, T, D, D, nullptr}; pg8::StaticOrder S; S.init(T, D, G, bx, -1);
        pg8::EpiResid E{X, X1B};
        pg8::gemm_phase<pg8::EpiResid>(lds, g, S, E);
    }
    STAMP_AT(104);
    SEAM_GROUP_ARRIVE(4, 2);
#ifdef EXTRA_BARS
    for (int xb = 0; xb < EXTRA_BARS; ++xb) GRID_BAR();
#endif

    STAMP_AT(5);
#if P5_MFMA
    if (IN(5)) {
        LAS unsigned char* wq = lds;
        if (!(IN(4) && MK_MODE == 2)) __syncthreads();
        for (int k = tid; k < D; k += 512) { const float gk = args.in[10][k]; const int ks = k >> 5, kk = k & 31;
#pragma unroll
            for (int e4 = 0; e4 < 16; e4 += 4) { const f32x4 w = *(const f32x4*)(args.in[11] + k * 16 + e4);
#pragma unroll
                for (int j = 0; j < 4; ++j) { const float wp = w[j] * gk; const unsigned hi = cvt_pk_fast(wp, 0.f) & 0xffffu; const unsigned lo = cvt_pk_fast(wp - __uint_as_float(hi << 16), 0.f) & 0xffffu;
                    *(LAS unsigned short*)(wq + ((ks * 2 + 0) * 16 + e4 + j) * 80 + kk * 2) = (unsigned short)hi;
                    *(LAS unsigned short*)(wq + ((ks * 2 + 1) * 16 + e4 + j) * 80 + kk * 2) = (unsigned short)lo; } } }
        SEAM_GROUP_WAIT(4, 2);
        __syncthreads();
        f32x4 gg[4];
#pragma unroll
        for (int j = 0; j < 4; ++j) gg[j] = *((const f32x4*)args.in[10] + lane + 64 * j);
        const int n_ = lane & 15, q_ = lane >> 4;
        const int rs5 = (G == 256) ? 8 : NGW, rb5 = (G == 256) ? (8 * (bx & 7) + ((bx >> 3) & 7)) * 256 + (bx >> 6) * 64 + wave : gw;
        for (int base = rb5; base < T; base += (G == 256) ? T : 8 * NGW) {
            u32x4 xa[16];
            { const int ri = n_ & 7, kh = n_ >> 3; const int rowA = (base + ri * rs5 < T) ? base + ri * rs5 : base;
              const bf16_t* ap = X1B + (size_t)rowA * D + 512 * kh + 8 * q_;
#pragma unroll
              for (int s5 = 0; s5 < 16; ++s5) xa[s5] = *(const u32x4*)(ap + 32 * s5); }
            u32x2 xw[2][4][4];
#pragma unroll
            for (int blk = 0; blk < 2; ++blk)
#pragma unroll
                for (int rr = 0; rr < 4; ++rr) { const int row = (base + (4 * blk + rr) * rs5 < T) ? base + (4 * blk + rr) * rs5 : base;
#pragma unroll
                    for (int j = 0; j < 4; ++j) xw[blk][rr][j] = *((const u32x2*)(X1B + (size_t)row * D) + lane + 64 * j); }
            float rv[8];
#pragma unroll
            for (int blk = 0; blk < 2; ++blk) {
                f32x4 v[4][4]; float ss[4];
#pragma unroll
                for (int rr = 0; rr < 4; ++rr) {
#pragma unroll
                    for (int j = 0; j < 4; ++j) { const u32x2 w2 = xw[blk][rr][j]; v[rr][j] = (f32x4){bf_lo(w2.x), bf_hi(w2.x), bf_lo(w2.y), bf_hi(w2.y)}; } }
#pragma unroll
                for (int rr = 0; rr < 4; ++rr) { float a = 0.f;
#pragma unroll
                    for (int j = 0; j < 4; ++j) a += (v[rr][j].x * v[rr][j].x + v[rr][j].y * v[rr][j].y) + (v[rr][j].z * v[rr][j].z + v[rr][j].w * v[rr][j].w);
                    ss[rr] = a; }
#pragma unroll
                for (int o = 1; o < 64; o <<= 1) {
#pragma unroll
                    for (int rr = 0; rr < 4; ++rr) ss[rr] += __shfl_xor(ss[rr], o); }
#pragma unroll
                for (int rr = 0; rr < 4; ++rr) { const int row = base + (4 * blk + rr) * rs5; const float r = 1.0f / sqrtf(ss[rr] * (1.0f / D) + EPS); rv[4 * blk + rr] = r;
#pragma unroll
                    for (int j = 0; j < 4; ++j) { v[rr][j] = v[rr][j] * r * gg[j];
                        if (row < T) *((unsigned*)((unsigned char*)H2 + (size_t)row * D) + lane + 64 * j) = cvt4_fp8(v[rr][j][0], v[rr][j][1], v[rr][j][2], v[rr][j][3]); } }
            }
            f32x4 c0 = {0.f, 0.f, 0.f, 0.f}, c1 = {0.f, 0.f, 0.f, 0.f};
#pragma unroll
            for (int s5 = 0; s5 < 16; ++s5) { const bf16x8 af = __builtin_bit_cast(bf16x8, xa[s5]);
#pragma unroll
                for (int part = 0; part < 2; ++part) {
                    const bf16x8 b0 = *(const LAS bf16x8*)(wq + ((s5 * 2 + part) * 16 + n_) * 80 + 16 * q_);
                    const bf16x8 b1 = *(const LAS bf16x8*)(wq + (((16 + s5) * 2 + part) * 16 + n_) * 80 + 16 * q_);
                    c0 = __builtin_amdgcn_mfma_f32_16x16x32_bf16(af, b0, c0, 0, 0, 0); c1 = __builtin_amdgcn_mfma_f32_16x16x32_bf16(af, b1, c1, 0, 0, 0); } }
#pragma unroll
            for (int t5 = 0; t5 < 4; ++t5) { const float lg = (c0[t5] + __shfl_xor(c1[t5], 32)) * ((q_ == 0) ? rv[t5] : rv[4 + t5]);
                float mx = lg;
#pragma unroll
                for (int o = 8; o >= 1; o >>= 1) mx = fmaxf(mx, __shfl_xor(mx, o));
                const float pe = __expf(lg - mx); float den = pe;
#pragma unroll
                for (int o = 8; o >= 1; o >>= 1) den += __shfl_xor(den, o);
                const int row = base + (4 * q_ + t5) * rs5;
                if (q_ < 2 && row < T) AFF[((size_t)(row >> 12) * NE + n_) * SEQ + (row & (SEQ - 1))] = pe / den; }
        }
    }
#else
    if (IN(5)) {
#if MK_MODE == 2
#error "the packed-FMA P5 path keeps the grid-wide row mapping: use P5_MFMA 1 with the group rendezvous"
#endif
        SEAM(4);
        LAS float* wrt = (LAS float*)lds;
        __syncthreads();
        for (int cc = tid; cc < 1024; cc += 512) {
#pragma unroll
            for (int e4 = 0; e4 < 16; e4 += 4) { const f32x4 w = *(const f32x4*)(args.in[11] + cc * 16 + e4);
                wrt[(e4 + 0) * 1024 + cc] = w[0]; wrt[(e4 + 1) * 1024 + cc] = w[1]; wrt[(e4 + 2) * 1024 + cc] = w[2]; wrt[(e4 + 3) * 1024 + cc] = w[3]; } }
        __syncthreads();
        f32x4 gg[4];
#pragma unroll
        for (int j = 0; j < 4; ++j) gg[j] = *((const f32x4*)args.in[10] + lane + 64 * j);
        u32x2 nxw[4][4];
#pragma unroll
        for (int rr = 0; rr < 4; ++rr) { const int row = (gw + rr * NGW < T) ? gw + rr * NGW : gw;
#pragma unroll
            for (int j = 0; j < 4; ++j) nxw[rr][j] = *((const u32x2*)(X1B + (size_t)row * D) + lane + 64 * j); }
        for (int row0 = gw; row0 < T; row0 += 4 * NGW) {
            f32x4 v[4][4]; float ss[4];
#pragma unroll
            for (int rr = 0; rr < 4; ++rr) {
#pragma unroll
                for (int j = 0; j < 4; ++j) { const u32x2 xw = nxw[rr][j]; v[rr][j] = (f32x4){bf_lo(xw.x), bf_hi(xw.x), bf_lo(xw.y), bf_hi(xw.y)}; } }
            { const int rown0 = (row0 + 4 * NGW < T) ? row0 + 4 * NGW : row0;
#pragma unroll
              for (int rr = 0; rr < 4; ++rr) { const int row = (rown0 + rr * NGW < T) ? rown0 + rr * NGW : rown0;
#pragma unroll
                  for (int j = 0; j < 4; ++j) nxw[rr][j] = *((const u32x2*)(X1B + (size_t)row * D) + lane + 64 * j); } }
#pragma unroll
            for (int rr = 0; rr < 4; ++rr) { float a = 0.f;
#pragma unroll
                for (int j = 0; j < 4; ++j) a += (v[rr][j].x * v[rr][j].x + v[rr][j].y * v[rr][j].y) + (v[rr][j].z * v[rr][j].z + v[rr][j].w * v[rr][j].w);
                ss[rr] = a; }
#pragma unroll
            for (int o = 1; o < 64; o <<= 1) {
#pragma unroll
                for (int rr = 0; rr < 4; ++rr) ss[rr] += __shfl_xor(ss[rr], o); }
#pragma unroll
            for (int rr = 0; rr < 4; ++rr) { const int row = row0 + rr * NGW; const float r = 1.0f / sqrtf(ss[rr] * (1.0f / D) + EPS);
#pragma unroll
                for (int j = 0; j < 4; ++j) { v[rr][j] = v[rr][j] * r * gg[j];
#if MOE_FP8
                    if (row < T) *((unsigned*)((unsigned char*)H2 + (size_t)row * D) + lane + 64 * j) = cvt4_fp8(v[rr][j][0], v[rr][j][1], v[rr][j][2], v[rr][j][3]);
#else
                    if (row < T) { u32x2 w; w.x = cvt_pk_bf16(v[rr][j][0], v[rr][j][1]); w.y = cvt_pk_bf16(v[rr][j][2], v[rr][j][3]); *((u32x2*)(H2 + (size_t)row * D) + lane + 64 * j) = w; }
#endif
                } }
            float val[64];
#pragma unroll
            for (int e = 0; e < 16; ++e) { f32x2 a0 = {0.f, 0.f}, a1 = {0.f, 0.f}, a2 = {0.f, 0.f}, a3 = {0.f, 0.f};
#pragma unroll
                for (int j = 0; j < 4; ++j) { const f32x4 w = *(const LAS f32x4*)(wrt + e * 1024 + 4 * lane + 256 * j); const f32x2 wl = {w[0], w[1]}, wh = {w[2], w[3]};
                    a0 += (f32x2){v[0][j][0], v[0][j][1]} * wl; a0 += (f32x2){v[0][j][2], v[0][j][3]} * wh; a1 += (f32x2){v[1][j][0], v[1][j][1]} * wl; a1 += (f32x2){v[1][j][2], v[1][j][3]} * wh;
                    a2 += (f32x2){v[2][j][0], v[2][j][1]} * wl; a2 += (f32x2){v[2][j][2], v[2][j][3]} * wh; a3 += (f32x2){v[3][j][0], v[3][j][1]} * wl; a3 += (f32x2){v[3][j][2], v[3][j][3]} * wh; }
                val[e] = a0[0] + a0[1]; val[16 + e] = a1[0] + a1[1]; val[32 + e] = a2[0] + a2[1]; val[48 + e] = a3[0] + a3[1]; }
#pragma unroll
            for (int off = 32, n = 64; off >= 1; off >>= 1, n >>= 1) { const bool up = (lane & off) != 0;
#pragma unroll
                for (int k = 0; k < n / 2; ++k) { const float a = val[k], bq = val[k + n / 2]; const float send = up ? a : bq, keep = up ? bq : a; val[k] = keep + __shfl_xor(send, off); } }
            const float lg = val[0];
            float mx = lg;
#pragma unroll
            for (int o = 8; o >= 1; o >>= 1) mx = fmaxf(mx, __shfl_xor(mx, o));
            const float pe = __expf(lg - mx); float den = pe;
#pragma unroll
            for (int o = 8; o >= 1; o >>= 1) den += __shfl_xor(den, o);
            const int row = row0 + (lane >> 4) * NGW;
            if (row < T) AFF[((size_t)(row >> 12) * NE + (lane & 15)) * SEQ + (row & (SEQ - 1))] = pe / den;
        }
    }
#endif
    SEAM(5);

    STAMP_AT(6);
    if (IN(6)) {
        const int ntk = (G > 64) ? 64 : G;
        if (bx >= ntk || G <= 64) {
            const int cw = (G > 64) ? bx - ntk : bx, ncw = (G > 64) ? G - ntk : G;
#if MOE_FP8
            { LAS unsigned char* scr8 = lds + 1024 + wave * 16640;
              constexpr int P6_DN = 2048 - 512;
              for (int it8 = cw * NWAVES + wave; it8 < P6_DN; it8 += ncw * NWAVES) expert_tile8(4096 + it8, args.in[12], args.in[13], args.in[14], (unsigned char*)WGU, (unsigned char*)WDT, scr8, lane); }
#else
            LAS float* scr = (LAS float*)(lds + 1024 + wave * 16640);
            int it = cw * NWAVES + wave; TileRegs tr; ExTile xt;
            if (it < 4096) { xt = expert_tile(8192 + it, args.in[12], args.in[13], args.in[14], WGU, WDT); tile_load(tr, xt.W, xt.N, xt.k0, xt.n0, lane); }
            while (it < 4096) { const ExTile xc = xt; const TileRegs tc = tr; it += ncw * NWAVES;
                if (it < 4096) { xt = expert_tile(8192 + it, args.in[12], args.in[13], args.in[14], WGU, WDT); tile_load(tr, xt.W, xt.N, xt.k0, xt.n0, lane); }
                tile_store(tc, xc.k0, xc.WT, xc.Kd, xc.drow0, scr, lane); }
#endif
        }
        for (int item = bx; item < 64 && bx < ntk; item += ntk) {
            const int be = item, b = be >> 4, e = be & 15;
            LAS int* wsum = (LAS int*)lds;
            LAS int* idxl = (LAS int*)(lds + 512);
            __syncthreads();
            unsigned v[8];
            { const float* ap = AFF + (size_t)be * SEQ + 8 * tid; const f32x4 a0 = *(const f32x4*)ap, a1 = *(const f32x4*)(ap + 4);
#pragma unroll
              for (int i = 0; i < 4; ++i) { v[i] = __float_as_uint(a0[i]); v[4 + i] = __float_as_uint(a1[i]); } }
            unsigned prefix = 0u;
            for (int rd = 0; rd < 16; ++rd) {
                const int b = (rd == 0) ? 30 : 30 - 2 * rd;
                const unsigned c1 = prefix | (1u << b), c2 = prefix | (2u << b), c3 = prefix | (3u << b);
                int n1 = 0, n2 = 0, n3 = 0;
#pragma unroll
                for (int i = 0; i < 8; ++i) { n1 += __builtin_popcountll(__ballot(v[i] >= c1)); if (rd) { n2 += __builtin_popcountll(__ballot(v[i] >= c2)); n3 += __builtin_popcountll(__ballot(v[i] >= c3)); } }
                LAS int* wt = wsum + (rd & 1) * 24;
                if (lane == 0) { wt[wave] = n1; wt[8 + wave] = n2; wt[16 + wave] = n3; }
                __syncthreads();
                int t1 = 0, t2 = 0, t3 = 0;
#pragma unroll
                for (int w = 0; w < 8; ++w) { t1 += wt[w]; t2 += wt[8 + w]; t3 += wt[16 + w]; }
                if (rd == 0) { if (t1 >= CAP) prefix = c1; }
                else prefix = (t3 >= CAP) ? c3 : ((t2 >= CAP) ? c2 : ((t1 >= CAP) ? c1 : prefix));
            }
            const unsigned tau = prefix;
            int cgt = 0, ceq = 0;
#pragma unroll
            for (int i = 0; i < 8; ++i) { cgt += (v[i] > tau) ? 1 : 0; ceq += (v[i] == tau) ? 1 : 0; }
            int sce = ceq;
#pragma unroll
            for (int o = 1; o < 64; o <<= 1) { const int y = __shfl_up(sce, o); if (lane >= o) sce += y; }
            const int wgt = wave_sum_i(cgt);
            if (lane == 63) wsum[48 + wave] = sce;
            if (lane == 0) wsum[56 + wave] = wgt;
            __syncthreads();
            int ngt = 0, eqbase = sce - ceq;
#pragma unroll
            for (int w = 0; w < 8; ++w) { ngt += wsum[56 + w]; eqbase += (w < wave) ? wsum[48 + w] : 0; }
            const int need = CAP - ngt;
            unsigned selm = 0u; int nsel = 0, er = eqbase;
#pragma unroll
            for (int i = 0; i < 8; ++i) { bool sel = v[i] > tau; if (v[i] == tau) { sel = er < need; ++er; } if (sel) { selm |= (1u << i); ++nsel; } }
            int scs = nsel;
#pragma unroll
            for (int o = 1; o < 64; o <<= 1) { const int y = __shfl_up(scs, o); if (lane >= o) scs += y; }
            if (lane == 63) wsum[64 + wave] = scs;
            __syncthreads();
            int slot = scs - nsel;
#pragma unroll
            for (int w = 0; w < 8; ++w) slot += (w < wave) ? wsum[64 + w] : 0;
            unsigned spk[4];
#pragma unroll
            for (int i = 0; i < 8; ++i) { const int tok = 8 * tid + i; const bool sel = (selm >> i) & 1u;
                if (sel) { GATE[(size_t)(e * NB + b) * CAP + slot] = __uint_as_float(v[i]); ROWTOK[(size_t)(e * NB + b) * CAP + slot] = b * SEQ + tok; }
                const unsigned sv = sel ? (unsigned)slot & 0xffffu : 0xffffu; if (i & 1) spk[i >> 1] |= sv << 16; else spk[i >> 1] = sv;
                if (sel) ++slot; }
            *(u32x4*)(SLOT + (size_t)be * SEQ + 8 * tid) = (u32x4){spk[0], spk[1], spk[2], spk[3]};
            (void)idxl;
        }
    }
    STAMP_AT(106);
    SEAM(6);

    STAMP_AT(7);
    if (IN(7)) {
        pg8::Gemm g{H2, WGU, MROWS, 2 * EH, MOE_FP8 ? D / 2 : D, ROWTOK}; pg8::StaticOrder S; S.init(MROWS, 2 * EH, G, bx, 3);
        pg8::EpiSwiGLU E{ACT};
        pg8::gemm_phase<pg8::EpiSwiGLU, true, true, true, MOE_FP8 != 0>(lds, g, S, E);
    }
    SEAM_GROUP(7, 1);

    STAMP_AT(8);
    if (IN(8)) {
        pg8::Gemm g{ACT, WDT, MROWS, D, MOE_FP8 ? EH / 2 : EH, nullptr}; pg8::StaticOrder S; S.init(MROWS, D, G, bx, 3);
        pg8::EpiDown E{YB, GATE};
        pg8::gemm_phase<pg8::EpiDown, true, true, false, MOE_FP8 != 0>(lds, g, S, E);
    }
    STAMP_AT(108);
    SEAM(8);

    STAMP_AT(9);
    if (IN(9)) {
        f32x4 gg[4];
#pragma unroll
        for (int j = 0; j < 4; ++j) gg[j] = *((const f32x4*)args.in[15] + lane + 64 * j);
        u32x2 nx9[4]; int nsl[16];
#pragma unroll
        for (int j = 0; j < 4; ++j) nx9[j] = *((const u32x2*)(X1B + (size_t)gw * D) + lane + 64 * j);
#pragma unroll
        for (int e = 0; e < 16; ++e) nsl[e] = SLOT[((size_t)(gw >> 12) * NE + e) * SEQ + (gw & (SEQ - 1))];
        for (int row = gw; row < T; row += NGW) {
            const int b = row >> 12; const int rn = (row + NGW < T) ? row + NGW : row;
            f32x4 v[4]; int sl[16];
#pragma unroll
            for (int j = 0; j < 4; ++j) v[j] = (f32x4){bf_lo(nx9[j].x), bf_hi(nx9[j].x), bf_lo(nx9[j].y), bf_hi(nx9[j].y)};
#pragma unroll
            for (int e = 0; e < 16; ++e) sl[e] = nsl[e];
#pragma unroll
            for (int j = 0; j < 4; ++j) nx9[j] = *((const u32x2*)(X1B + (size_t)rn * D) + lane + 64 * j);
#pragma unroll
            for (int e = 0; e < 16; ++e) nsl[e] = SLOT[((size_t)(rn >> 12) * NE + e) * SEQ + (rn & (SEQ - 1))];
#pragma unroll
            for (int e = 0; e < 16; ++e) { const int s1 = __builtin_amdgcn_readfirstlane(sl[e]);
                if (s1 >= 0) { const bf16_t* yp = YB + ((size_t)(e * NB + b) * CAP + s1) * D + 4 * lane;
#pragma unroll
                    for (int j = 0; j < 4; ++j) { const u32x2 yw = __builtin_nontemporal_load((const u32x2*)(yp + 256 * j)); v[j][0] += bf_lo(yw.x); v[j][1] += bf_hi(yw.x); v[j][2] += bf_lo(yw.y); v[j][3] += bf_hi(yw.y); } } }
            float s = 0.f;
#pragma unroll
            for (int j = 0; j < 4; ++j) s += (v[j].x * v[j].x + v[j].y * v[j].y) + (v[j].z * v[j].z + v[j].w * v[j].w);
            const float r = 1.0f / sqrtf(wave_sum(s) * (1.0f / D) + EPS);
#pragma unroll
            for (int j = 0; j < 4; ++j) __builtin_nontemporal_store(v[j] * r * gg[j], (f32x4*)(OUT + (size_t)row * D) + lane + 64 * j);
        }
    }
    STAMP_AT(10);
#ifdef STAMP_LO
    if (bx == STAMP_BLK && tid == 0) { const unsigned long long t0 = __builtin_amdgcn_s_memrealtime(), want = (ts1 - ts0) * STAMP_AMP; while (__builtin_amdgcn_s_memrealtime() - t0 < want) __builtin_amdgcn_s_sleep(8); }
#endif
#undef IN
#undef SEAM
}

extern "C" void kernel_launch(void* const* d_in, const int* in_sizes, int n_in, void* d_out, int out_size, void* d_ws, size_t ws_size, hipStream_t stream) {
    static int grid = 0;
    if (grid == 0) {
        if (n_in != 16 || in_sizes[0] != T * D || out_size != T * D || ws_size < WS_END) { fprintf(stderr, "kernel_launch: unexpected shapes (n_in %d, in0 %d, out %d, ws %zu < %zu)\n", n_in, n_in > 0 ? in_sizes[0] : -1, out_size, ws_size, (size_t)WS_END); grid = -1; return; }
        int dev = 0, cus = 0, per_cu = 0;
        if (hipGetDevice(&dev) != hipSuccess || hipDeviceGetAttribute(&cus, hipDeviceAttributeMultiprocessorCount, dev) != hipSuccess) { grid = -1; return; }
        if (hipFuncSetAttribute((const void*)mk_fwd, hipFuncAttributeMaxDynamicSharedMemorySize, LDS_BYTES) != hipSuccess) { fprintf(stderr, "kernel_launch: hipFuncSetAttribute failed\n"); grid = -1; return; }
        if (hipOccupancyMaxActiveBlocksPerMultiprocessor(&per_cu, (const void*)mk_fwd, NWAVES * 64, LDS_BYTES) != hipSuccess || per_cu < 1) { fprintf(stderr, "kernel_launch: occupancy query says %d blocks/CU\n", per_cu); per_cu = 1; }
        (void)hipGetLastError();
        grid = cus;
    }
    if (grid < 0) return;
    (void)hipMemsetAsync((char*)d_ws + WS_CTL, 0, 1 * MiB, stream);
    Args a{};
    for (int i = 0; i < 16; ++i) a.in[i] = (const float*)d_in[i];
    a.out = (float*)d_out; a.ws = (unsigned char*)d_ws;
#if MK_MODE == 0
    for (int p = 0; p < NPH; ++p) { a.ph_lo = p; a.ph_hi = p + 1; hipLaunchKernelGGL(mk_fwd, dim3(grid), dim3(NWAVES * 64), LDS_BYTES, stream, a); }
#elif MK_MODE == 1
    a.ph_lo = 0; a.ph_hi = NPH;
    void* kargs[] = {&a};
    hipError_t e = hipLaunchCooperativeKernel((const void*)mk_fwd, dim3(grid), dim3(NWAVES * 64), kargs, LDS_BYTES, stream);
    if (e != hipSuccess) fprintf(stderr, "kernel_launch: cooperative launch failed: %s\n", hipGetErrorString(e));
#else
    a.ph_lo = 0; a.ph_hi = NPH;
    hipLaunchKernelGGL(mk_fwd, dim3(grid), dim3(NWAVES * 64), LDS_BYTES, stream, a);
#endif
}
```
